# Optimizing an MI355X kernel written in HIP

```python
import math
import jax
import jax.numpy as jnp
from jax import lax
import numpy as np

D_MODEL = 1024
BATCH = 4
SEQ = 8192
DEPTH = 4

HEAD_DIM = 64
DA_HEADS = 8
DA_VDIM = 2 * HEAD_DIM
SW_Q_HEADS = 16
SW_KV_HEADS = 4
SW_GROUP = SW_Q_HEADS // SW_KV_HEADS
WINDOW = 128
Q_BLOCK = 128
D_FF = 2816
CONV_W = 3
ROPE_THETA = 10000.0
NORM_EPS = 1e-6
SUBLN_EPS = 1e-5
N_BRANCH = 2
N_MOD = 6

DA_QK = DA_HEADS * 2 * HEAD_DIM
DA_V = DA_HEADS * DA_VDIM
SW_Q = SW_Q_HEADS * HEAD_DIM
SW_KV = SW_KV_HEADS * HEAD_DIM
IN_SIZES = (DA_QK, DA_QK, DA_V, SW_Q, SW_KV, SW_KV, N_BRANCH * D_MODEL)
IN_WIDTH = sum(IN_SIZES)
IN_SPLITS = tuple(int(s) for s in np.cumsum(IN_SIZES)[:-1])

kernel_name = 'hybrid_diffattn_swa_sinks_convffn'


def rmsnorm(x, g, eps=NORM_EPS):
    xf = x.astype(jnp.float32)
    y = xf * lax.rsqrt(jnp.mean(xf * xf, axis=-1, keepdims=True) + eps)
    return y.astype(x.dtype) * g


def rope_tables(positions):
    inv_freq = ROPE_THETA ** (-jnp.arange(0, HEAD_DIM, 2, dtype=jnp.float32) / HEAD_DIM)
    ang = positions.astype(jnp.float32)[..., None] * inv_freq
    return jnp.cos(ang), jnp.sin(ang)


def apply_rope(x, cos, sin):
    extra = x.ndim - 3
    shp = cos.shape[:2] + (1,) * extra + cos.shape[2:]
    cos = cos.reshape(shp).astype(x.dtype)
    sin = sin.reshape(shp).astype(x.dtype)
    x1, x2 = jnp.split(x, 2, axis=-1)
    return jnp.concatenate([x1 * cos - x2 * sin, x2 * cos + x1 * sin], axis=-1)


def diff_attention(q, k, v, lam, subln_g, lambda_init):
    B, S = q.shape[0], q.shape[1]
    nblk = S // Q_BLOCK
    scale = HEAD_DIM ** -0.5
    qb = q.reshape(B, nblk, Q_BLOCK, DA_HEADS, 2, HEAD_DIM).transpose(1, 0, 2, 3, 4, 5)
    kpos = jnp.arange(S)

    def one_block(args):
        qi, blk = args
        s = jnp.einsum('bqhcd,bkhcd->bhcqk', qi, k).astype(jnp.float32) * scale
        qpos = blk * Q_BLOCK + jnp.arange(Q_BLOCK)
        causal = kpos[None, :] <= qpos[:, None]
        s = jnp.where(causal, s, -jnp.inf)
        p = jax.nn.softmax(s, axis=-1)
        w = p[:, :, 0] - lam * p[:, :, 1]
        return jnp.einsum('bhqk,bkhe->bqhe', w.astype(v.dtype), v)

    o = lax.map(one_block, (qb, jnp.arange(nblk)))
    o = o.transpose(1, 0, 2, 3, 4).reshape(B, S, DA_HEADS, DA_VDIM)
    o = rmsnorm(o, subln_g, SUBLN_EPS) * (1.0 - lambda_init)
    return o.reshape(B, S, DA_V)


def sliding_window_attention(q, k, v, sinks):
    B, S = q.shape[0], q.shape[1]
    nblk = S // Q_BLOCK
    scale = HEAD_DIM ** -0.5
    qb = q.reshape(B, nblk, Q_BLOCK, SW_KV_HEADS, SW_GROUP, HEAD_DIM)
    pad = jnp.zeros((B, Q_BLOCK, SW_KV_HEADS, HEAD_DIM), k.dtype)
    kp = jnp.concatenate([pad, k], axis=1).reshape(B, nblk + 1, Q_BLOCK, SW_KV_HEADS, HEAD_DIM)
    vp = jnp.concatenate([pad, v], axis=1).reshape(B, nblk + 1, Q_BLOCK, SW_KV_HEADS, HEAD_DIM)
    kb = jnp.concatenate([kp[:, :-1], kp[:, 1:]], axis=2)
    vb = jnp.concatenate([vp[:, :-1], vp[:, 1:]], axis=2)
    s = jnp.einsum('bnqhgd,bnkhd->bnhgqk', qb, kb).astype(jnp.float32) * scale
    i = jnp.arange(Q_BLOCK)[:, None]
    j = jnp.arange(2 * Q_BLOCK)[None, :]
    band = (j > i) & (j <= i + WINDOW)
    kabs = jnp.arange(nblk)[:, None, None] * Q_BLOCK + j[None] - Q_BLOCK
    mask = band[None] & (kabs >= 0)
    s = jnp.where(mask[None, :, None, None], s, -jnp.inf)
    sink = jnp.broadcast_to(sinks.astype(jnp.float32).reshape(1, 1, SW_KV_HEADS, SW_GROUP, 1, 1),
                            s.shape[:-1] + (1,))
    p = jax.nn.softmax(jnp.concatenate([s, sink], axis=-1), axis=-1)[..., :-1]
    o = jnp.einsum('bnhgqk,bnkhd->bnqhgd', p.astype(v.dtype), vb)
    return o.reshape(B, S, SW_Q)


def conv_ffn(h, w_gate, w_up, conv_w, conv_b, w_down):
    S = h.shape[1]
    g = h @ w_gate
    u = h @ w_up
    gp = jnp.pad(g, ((0, 0), (CONV_W - 1, 0), (0, 0)))
    gc = conv_b + conv_w[0] * gp[:, 0:S]
    for t in range(1, CONV_W):
        gc = gc + conv_w[t] * gp[:, t:t + S]
    return (jax.nn.silu(gc) * u) @ w_down


def setup_inputs(seed: int = 0) -> dict:
    key = jax.random.key(seed)
    ks = jax.random.split(key, 20)
    f32 = jnp.float32
    nrm = lambda k, shape, s: (jax.random.normal(k, shape, f32) * s).astype(f32)
    x = nrm(ks[0], (BATCH, SEQ, D_MODEL), 1.0)
    c = nrm(ks[1], (BATCH, D_MODEL), 1.0)
    offset = jax.random.randint(ks[2], (BATCH, 1), 0, 4096, dtype=jnp.int32)
    positions = (offset + jnp.arange(SEQ, dtype=jnp.int32)[None, :]).astype(jnp.int32)
    return {
        'x': x,
        'c': c,
        'positions': positions,
        'w_ada': nrm(ks[3], (DEPTH, D_MODEL, N_MOD * D_MODEL), 0.5 * D_MODEL ** -0.5),
        'b_ada': nrm(ks[4], (DEPTH, N_MOD * D_MODEL), 0.02),
        'attn_norm': 1.0 + nrm(ks[5], (DEPTH, D_MODEL), 0.02),
        'w_in': nrm(ks[6], (DEPTH, D_MODEL, IN_WIDTH), D_MODEL ** -0.5),
        'lambda_qk': nrm(ks[7], (DEPTH, 4, HEAD_DIM), 0.1),
        'subln_norm': 1.0 + nrm(ks[8], (DEPTH, DA_VDIM), 0.02),
        'sinks': nrm(ks[9], (DEPTH, SW_Q_HEADS), 0.5),
        'w_branch_a': nrm(ks[10], (DEPTH, DA_V, D_MODEL), DA_V ** -0.5),
        'w_branch_b': nrm(ks[11], (DEPTH, SW_Q, D_MODEL), SW_Q ** -0.5),
        'w_out': nrm(ks[12], (DEPTH, D_MODEL, D_MODEL), D_MODEL ** -0.5),
        'ffn_norm': 1.0 + nrm(ks[13], (DEPTH, D_MODEL), 0.02),
        'w_gate': nrm(ks[14], (DEPTH, D_MODEL, D_FF), D_MODEL ** -0.5),
        'w_up': nrm(ks[15], (DEPTH, D_MODEL, D_FF), D_MODEL ** -0.5),
        'conv_w': nrm(ks[16], (DEPTH, CONV_W, D_FF), CONV_W ** -0.5),
        'conv_b': nrm(ks[17], (DEPTH, D_FF), 0.02),
        'w_down': nrm(ks[18], (DEPTH, D_FF, D_MODEL), D_FF ** -0.5),
        'final_norm': 1.0 + nrm(ks[19], (D_MODEL,), 0.02),
    }


def reference(x, c, positions, w_ada, b_ada, attn_norm, w_in, lambda_qk, subln_norm, sinks,
              w_branch_a, w_branch_b, w_out, ffn_norm, w_gate, w_up, conv_w, conv_b, w_down,
              final_norm):
    B, S = x.shape[0], x.shape[1]
    cos, sin = rope_tables(positions)
    c_act = jax.nn.silu(c)
    for l in range(DEPTH):
        mod = (c_act @ w_ada[l] + b_ada[l])[:, None, :]
        sh1, sc1, g1, sh2, sc2, g2 = jnp.split(mod, N_MOD, axis=-1)

        h = rmsnorm(x, attn_norm[l]) * (1.0 + sc1) + sh1
        proj = h @ w_in[l]
        qa, ka, va, qs, ksw, vsw, gates = jnp.split(proj, IN_SPLITS, axis=-1)

        lambda_init = 0.8 - 0.6 * math.exp(-0.3 * l)
        lq = lambda_qk[l].astype(jnp.float32)
        lam = jnp.exp(jnp.sum(lq[0] * lq[1])) - jnp.exp(jnp.sum(lq[2] * lq[3])) + lambda_init
        qa = apply_rope(qa.reshape(B, S, DA_HEADS, 2, HEAD_DIM), cos, sin)
        ka = apply_rope(ka.reshape(B, S, DA_HEADS, 2, HEAD_DIM), cos, sin)
        va = va.reshape(B, S, DA_HEADS, DA_VDIM)
        oa = diff_attention(qa, ka, va, lam, subln_norm[l], lambda_init)

        qs = apply_rope(qs.reshape(B, S, SW_Q_HEADS, HEAD_DIM), cos, sin)
        qs = qs.reshape(B, S, SW_KV_HEADS, SW_GROUP, HEAD_DIM)
        ksw = apply_rope(ksw.reshape(B, S, SW_KV_HEADS, HEAD_DIM), cos, sin)
        vsw = vsw.reshape(B, S, SW_KV_HEADS, HEAD_DIM)
        ob = sliding_window_attention(qs, ksw, vsw, sinks[l])

        ga, gb = jnp.split(jax.nn.sigmoid(gates), N_BRANCH, axis=-1)
        mixed = ga * (oa @ w_branch_a[l]) + gb * (ob @ w_branch_b[l])
        x = x + g1 * (mixed @ w_out[l])

        h = rmsnorm(x, ffn_norm[l]) * (1.0 + sc2) + sh2
        x = x + g2 * conv_ffn(h, w_gate[l], w_up[l], conv_w[l], conv_b[l], w_down[l])
    return rmsnorm(x, final_norm)
```

```cpp
#include <hip/hip_runtime.h>
#include <cstdio>
#include <cstdint>
namespace pg8 {
#define PG8_LAS __attribute__((address_space(3)))
typedef unsigned short bf16_t;
typedef short bf16x8 __attribute__((ext_vector_type(8)));
typedef float f32x4 __attribute__((ext_vector_type(4)));
typedef unsigned u32x4 __attribute__((ext_vector_type(4)));
constexpr int BM = 256, BK = 64, HALF = 128, HTB = HALF * BK * 2  , STAGE_BYTES = 8 * HTB, NXCD = 8, WGM = 8;

__host__ __device__ __forceinline__ int lds_byte(int r, int c) { const int st = (r >> 4) * 2 + (c >> 5), rr = r & 15, cc = c & 31, ob = rr * 64 + cc * 2; return st * 1024 + (ob ^ (((ob >> 9) & 1) << 5)); }
__host__ __device__ __forceinline__ void stage_rc(int b, int& R, int& C) { const int st = b / 1024, sb = b % 1024, swz = sb ^ (((sb >> 9) & 1) << 5); R = (st >> 1) * 16 + swz / 64; C = (st & 1) * 32 + (swz % 64) / 2; }
__host__ __device__ __forceinline__ int perm32(int rho) { const int n = rho >> 4, i = rho & 15; return 8 * (i >> 2) + 4 * n + (i & 3); }

struct Unit { int pm, pn, br; };
struct Gemm { const bf16_t* A; const bf16_t* Bt; int lda, ldb, K; size_t abr, bbr; };

struct StaticOrder {
    int nM, nN, nwg, G, c;
    __host__ __device__ void init(int M, int N, int G_, int c_) { nM = M / BM; nN = N / BM; nwg = nM * nN; G = G_; c = c_; }
    __host__ __device__ bool next(int i, Unit& u) const {
        const long L = (long)i * G + c; if (L >= nwg) return false;
        int wgid = (int)L; { const int q = nwg / NXCD, r = nwg % NXCD, xcd = wgid % NXCD, off = wgid / NXCD; wgid = (xcd < r ? xcd * (q + 1) : r * (q + 1) + (xcd - r) * q) + off; }
        const int nig = WGM * nN, gid = wgid / nig, fm = gid * WGM, gsz = (nM - fm) < WGM ? (nM - fm) : WGM;
        u.pm = fm + ((wgid % nig) % gsz); u.pn = (wgid % nig) / gsz; u.br = 0; return true;
    }
    __device__ __forceinline__ void a_ready(const Unit&) const {}
    __device__ __forceinline__ void done(const Unit&) const {}
};

__device__ __forceinline__ unsigned cvt_pk_bf16(float lo, float hi) { unsigned r; asm volatile("v_cvt_pk_bf16_f32 %0, %1, %2" : "=v"(r) : "v"(lo), "v"(hi)); return r; }
typedef float f32x2 __attribute__((ext_vector_type(2)));
__device__ __forceinline__ f32x2 gelu_pk(f32x2 v) {
    const f32x2 av = __builtin_elementwise_abs(v), d = av * 0.2316418882f + 1.0f;
    f32x2 t; t.x = __builtin_amdgcn_rcpf(d.x); t.y = __builtin_amdgcn_rcpf(d.y);
    f32x2 q = t * 0.5307027145f + (-0.7265760135f); q = q * t + 0.7107068705f; q = q * t + (-0.142248368f); q = q * t + 0.127414796f; q = q * t;
    const f32x2 s = (v * v) * (-0.72134752044f);
    f32x2 e; e.x = __builtin_amdgcn_exp2f(s.x); e.y = __builtin_amdgcn_exp2f(s.y);
    const f32x2 m = v * (q * e), r = v - m;
    f32x2 o; o.x = v.x < 0.f ? m.x : r.x; o.y = v.y < 0.f ? m.y : r.y; return o;
}

template <int ACT  > struct EpiBf16 {
    static constexpr bool PERM = true, AFTER_DRAIN = false; static_assert(ACT == 0 || ACT == 1, "EpiBf16: ACT is 0 (none) or 1 (gelu_pk)");
    bf16_t* O; int ldc; const float* bias; int split_cols; size_t split_stride; float scale0;
    __device__ __forceinline__ void operator()(const f32x4 (&acc)[2][2][4][2], const Unit& u, int wr, int wc, int fr, int fq) const {
        const int row0 = u.pm * BM + wr * 64 + fr; int colt = u.pn * BM; bf16_t* base = O;
        float sc = 1.f; if (split_cols) { const int t = colt / split_cols; base += (size_t)t * split_stride; colt -= t * split_cols; if (t == 0) sc = scale0; }
        const int col0 = colt + wc * 32 + 8 * fq, bcol0 = u.pn * BM + wc * 32 + 8 * fq;
        f32x4 bv[2][2];
#pragma unroll
        for (int bj = 0; bj < 2; ++bj)
#pragma unroll
            for (int n = 0; n < 2; ++n) bv[bj][n] = bias ? *(const f32x4*)(bias + bcol0 + bj * HALF + 4 * n) : (f32x4){0.f, 0.f, 0.f, 0.f};
#pragma unroll
        for (int ai = 0; ai < 2; ++ai)
#pragma unroll
            for (int m = 0; m < 4; ++m) { bf16_t* rowp = base + (size_t)(row0 + ai * HALF + m * 16) * ldc + col0;
#pragma unroll
                for (int bj = 0; bj < 2; ++bj) { f32x4 v0 = acc[ai][bj][m][0] + bv[bj][0], v1 = acc[ai][bj][m][1] + bv[bj][1];
                    if (ACT == 1) { f32x2 a = gelu_pk((f32x2){v0[0], v0[1]}), b = gelu_pk((f32x2){v0[2], v0[3]}), c = gelu_pk((f32x2){v1[0], v1[1]}), d = gelu_pk((f32x2){v1[2], v1[3]});
                        v0 = (f32x4){a.x, a.y, b.x, b.y}; v1 = (f32x4){c.x, c.y, d.x, d.y}; }
                    v0 = v0 * sc; v1 = v1 * sc; u32x4 w; w.x = cvt_pk_bf16(v0[0], v0[1]); w.y = cvt_pk_bf16(v0[2], v0[3]); w.z = cvt_pk_bf16(v1[0], v1[1]); w.w = cvt_pk_bf16(v1[2], v1[3]);
                    *(u32x4*)(rowp + bj * HALF) = w; } }
    }
};
template <class Epi, class Sched, bool ALIGN_EPI = false, bool SP2 = false>
__device__ __forceinline__ void gemm_phase(PG8_LAS unsigned char* lds, const Gemm g, const Sched& S, const Epi& E) {
    int tid_ = threadIdx.x; asm volatile("" : "+v"(tid_)); const int tid = tid_, wid = __builtin_amdgcn_readfirstlane(tid >> 6), lane = tid & 63, wr = wid >> 2, wc = wid & 3, fr = lane & 15, fq = lane >> 4;
    const int K = g.K, nt = K / BK;
    unsigned voffA[2], voffB[2];
#pragma unroll
    for (int i = 0; i < 2; ++i) { int R, C; stage_rc(tid * 16 + i * 8192, R, C); const int Rb = Epi::PERM ? ((R & ~31) + perm32(R & 31)) : R;
        voffA[i] = (unsigned)(R * g.lda + C) * 2u; voffB[i] = (unsigned)(Rb * g.ldb + C) * 2u; }
    const size_t kstep = (size_t)(BK * 2);
    const size_t hstepA = (size_t)HALF * g.lda * 2, hstepB = (size_t)HALF * g.ldb * 2;
    const size_t tstepA = 2 * hstepA, tstepB = 2 * hstepB;
    const unsigned ldsw = (unsigned)wid * 1024u;
    const int aoff = lds_byte(wr * 64 + fr, fq * 8), boff = lds_byte(wc * 32 + fr, fq * 8);
#define PG8_SA(b, h) (((b) * 2 + (h)) * HTB)
#define PG8_SB(b, h) ((4 + (b) * 2 + (h)) * HTB)
#define PG8_STAGE(bufoff, gbase, voff) do { _Pragma("unroll") for (int _i = 0; _i < 2; ++_i) \
        __builtin_amdgcn_global_load_lds((const unsigned*)((const char*)(gbase) + (voff)[_i]), (PG8_LAS unsigned*)(lds + (bufoff) + ldsw + _i * 8192), 16, 0, 0); } while (0)
#define PG8_LDA(dst, b, h) do { _Pragma("unroll") for (int m = 0; m < 4; ++m) _Pragma("unroll") for (int k = 0; k < 2; ++k) dst[m][k] = *(const PG8_LAS bf16x8*)(lds + PG8_SA(b, h) + aoff + m * 2048 + k * 1024); } while (0)
#define PG8_LDB(dst, b, h) do { _Pragma("unroll") for (int n = 0; n < 2; ++n) _Pragma("unroll") for (int k = 0; k < 2; ++k) dst[n][k] = *(const PG8_LAS bf16x8*)(lds + PG8_SB(b, h) + boff + n * 2048 + k * 1024); } while (0)
#define PG8_MMA(ai, bj, At, Bt) do { __builtin_amdgcn_s_setprio(1); _Pragma("unroll") for (int m = 0; m < 4; ++m) _Pragma("unroll") for (int n = 0; n < 2; ++n) _Pragma("unroll") for (int k = 0; k < 2; ++k) \
        acc[ai][bj][m][n] = __builtin_amdgcn_mfma_f32_16x16x32_bf16(Bt[n][k], At[m][k], acc[ai][bj][m][n], 0, 0, 0); __builtin_amdgcn_s_setprio(0); } while (0)
#define PG8_WAIT_V(n) asm volatile("s_waitcnt vmcnt(" #n ")" ::: "memory")
#define PG8_WAIT_L(n) asm volatile("s_waitcnt lgkmcnt(" #n ")" ::: "memory")
#define PG8_BAR __builtin_amdgcn_s_barrier()
#define PG8_SCHED __builtin_amdgcn_sched_barrier(0)
    Unit cur, nxt; int ui = 0;
    if (!S.next(0, cur)) return;
    f32x4 acc[2][2][4][2];
#pragma unroll
    for (int a = 0; a < 2; ++a)
#pragma unroll
        for (int b = 0; b < 2; ++b)
#pragma unroll
            for (int m = 0; m < 4; ++m)
#pragma unroll
                for (int n = 0; n < 2; ++n) acc[a][b][m][n] = (f32x4){0.f, 0.f, 0.f, 0.f};
    bf16x8 At[4][2], B0[2][2], B1[2][2];
    const char* cA = (const char*)g.A + (size_t)cur.pm * tstepA + (size_t)cur.br * g.abr; const char* cB = (const char*)g.Bt + (size_t)cur.pn * tstepB + (size_t)cur.br * g.bbr;
    S.a_ready(cur);
    if constexpr (SP2) {
        PG8_STAGE(PG8_SB(0, 0), cB, voffB); PG8_STAGE(PG8_SB(0, 1), cB + hstepB, voffB); PG8_STAGE(PG8_SA(0, 0), cA, voffA); PG8_STAGE(PG8_SA(0, 1), cA + hstepA, voffA);
        if (wr == 1) PG8_BAR;
        PG8_WAIT_V(2); PG8_BAR;
        PG8_STAGE(PG8_SB(1, 0), cB + kstep, voffB); PG8_STAGE(PG8_SA(1, 0), cA + kstep, voffA); PG8_STAGE(PG8_SB(1, 1), cB + hstepB + kstep, voffB);
        PG8_WAIT_V(6); PG8_BAR;
    } else {
        PG8_STAGE(PG8_SB(0, 0), cB, voffB); PG8_STAGE(PG8_SA(0, 0), cA, voffA); PG8_STAGE(PG8_SB(0, 1), cB + hstepB, voffB); PG8_STAGE(PG8_SA(0, 1), cA + hstepA, voffA);
        if (wr == 1) PG8_BAR;
        PG8_WAIT_V(4); PG8_BAR;
        PG8_STAGE(PG8_SB(1, 0), cB + kstep, voffB); PG8_STAGE(PG8_SA(1, 0), cA + kstep, voffA); PG8_STAGE(PG8_SB(1, 1), cB + hstepB + kstep, voffB);
        PG8_WAIT_V(6); PG8_BAR;
    }
    for (;;) {
        const bool has_next = S.next(ui + 1, nxt);
        const char* nA = has_next ? (const char*)g.A + (size_t)nxt.pm * tstepA + (size_t)nxt.br * g.abr : cA; const char* nB = has_next ? (const char*)g.Bt + (size_t)nxt.pn * tstepB + (size_t)nxt.br * g.bbr : cB;
        for (int t = 0; t < nt; t += 2) {
            const bool last = (t == nt - 2);
            const char* a1 = cA + (size_t)(t + 1) * kstep;
            const char* a2 = last ? nA : cA + (size_t)(t + 2) * kstep; const char* b2 = last ? nB : cB + (size_t)(t + 2) * kstep;
            const char* a3 = a2 + kstep; const char* b3 = b2 + kstep;
            if (last && has_next) S.a_ready(nxt);
            if constexpr (SP2) {
            PG8_LDB(B0, 0, 0); PG8_LDB(B1, 0, 1); PG8_SCHED; PG8_LDA(At, 0, 0); PG8_STAGE(PG8_SA(1, 1), a1 + hstepA, voffA);
            PG8_WAIT_V(8); PG8_WAIT_L(0); PG8_BAR; PG8_MMA(0, 0, At, B0); PG8_MMA(0, 1, At, B1); PG8_BAR; PG8_SCHED;
            PG8_LDA(At, 0, 1); PG8_STAGE(PG8_SB(0, 0), b2, voffB); PG8_STAGE(PG8_SB(0, 1), b2 + hstepB, voffB); PG8_STAGE(PG8_SA(0, 0), a2, voffA);
            PG8_WAIT_V(8); PG8_WAIT_L(0); PG8_BAR; PG8_MMA(1, 0, At, B0); PG8_MMA(1, 1, At, B1); PG8_BAR; PG8_SCHED;
            PG8_LDB(B0, 1, 0); PG8_LDB(B1, 1, 1); PG8_SCHED; PG8_LDA(At, 1, 0); PG8_STAGE(PG8_SA(0, 1), a2 + hstepA, voffA);
            PG8_WAIT_V(8); PG8_WAIT_L(0); PG8_BAR; PG8_MMA(0, 0, At, B0); PG8_MMA(0, 1, At, B1); PG8_BAR; PG8_SCHED;
            PG8_LDA(At, 1, 1); PG8_STAGE(PG8_SB(1, 0), b3, voffB); PG8_STAGE(PG8_SB(1, 1), b3 + hstepB, voffB); PG8_STAGE(PG8_SA(1, 0), a3, voffA);
            PG8_WAIT_V(8); PG8_WAIT_L(0); PG8_BAR; PG8_MMA(1, 0, At, B0); PG8_MMA(1, 1, At, B1); PG8_BAR; PG8_SCHED;
            } else {
            PG8_LDB(B0, 0, 0); PG8_SCHED; PG8_LDA(At, 0, 0); PG8_STAGE(PG8_SA(1, 1), a1 + hstepA, voffA);
            PG8_WAIT_L(8); PG8_BAR; PG8_WAIT_L(0); PG8_MMA(0, 0, At, B0); PG8_BAR; PG8_SCHED;
            PG8_LDB(B1, 0, 1); PG8_STAGE(PG8_SB(0, 0), b2, voffB);
            PG8_BAR; PG8_WAIT_L(0); PG8_MMA(0, 1, At, B1); PG8_BAR;
            PG8_LDA(At, 0, 1); PG8_STAGE(PG8_SA(0, 0), a2, voffA);
            PG8_BAR; PG8_WAIT_L(0); PG8_MMA(1, 0, At, B0); PG8_BAR; PG8_SCHED;
            PG8_STAGE(PG8_SB(0, 1), b2 + hstepB, voffB);
            PG8_WAIT_V(6); PG8_BAR; PG8_MMA(1, 1, At, B1); PG8_BAR;
            PG8_LDB(B0, 1, 0); PG8_SCHED; PG8_LDA(At, 1, 0); PG8_STAGE(PG8_SA(0, 1), a2 + hstepA, voffA);
            PG8_WAIT_L(8); PG8_BAR; PG8_WAIT_L(0); PG8_MMA(0, 0, At, B0); PG8_BAR; PG8_SCHED;
            PG8_LDB(B1, 1, 1); PG8_STAGE(PG8_SB(1, 0), b3, voffB);
            PG8_BAR; PG8_WAIT_L(0); PG8_MMA(0, 1, At, B1); PG8_BAR;
            PG8_LDA(At, 1, 1); PG8_STAGE(PG8_SA(1, 0), a3, voffA);
            PG8_BAR; PG8_WAIT_L(0); PG8_MMA(1, 0, At, B0); PG8_BAR; PG8_SCHED;
            PG8_STAGE(PG8_SB(1, 1), b3 + hstepB, voffB);
            PG8_WAIT_V(6); PG8_BAR; PG8_MMA(1, 1, At, B1); PG8_BAR;
            }
        }
        if constexpr (ALIGN_EPI) { if (wr == 0) PG8_BAR; }
        if constexpr (!Epi::AFTER_DRAIN) { E(acc, cur, wr, wc, fr, fq); S.done(cur); }
        if (!has_next) break;
#pragma unroll
        for (int a = 0; a < 2; ++a)
#pragma unroll
            for (int b = 0; b < 2; ++b)
#pragma unroll
                for (int m = 0; m < 4; ++m)
#pragma unroll
                    for (int n = 0; n < 2; ++n) acc[a][b][m][n] = (f32x4){0.f, 0.f, 0.f, 0.f};
        cur = nxt; cA = nA; cB = nB; ++ui;
        if constexpr (ALIGN_EPI) { if (wr == 1) PG8_BAR; }
    }
    PG8_WAIT_V(0);
    if constexpr (!ALIGN_EPI) { if (wr == 0) PG8_BAR; }
    PG8_BAR;
    if constexpr (Epi::AFTER_DRAIN) { E.fused(acc, cur, wr, wc, fr, fq, lds, wid, lane); S.done(cur); }
#undef PG8_SA
#undef PG8_SB
#undef PG8_STAGE
#undef PG8_LDA
#undef PG8_LDB
#undef PG8_MMA
#undef PG8_WAIT_V
#undef PG8_WAIT_L
#undef PG8_BAR
#undef PG8_SCHED
}
}

#define PG8_SP2 true
#define PG8_ALIGN true

#define ATT_OFF_Q (94ull<<20)
#define ATT_OFF_K (158ull<<20)
#define ATT_OFF_V (222ull<<20)
#define ATT_OFF_O (30ull<<20)
#define ATT_OFF_SSQ (9ull<<20)
#include <hip/hip_bf16.h>
#include <cmath>
namespace attn_body {
using bf16=__hip_bfloat16;
using bf16x8=__attribute__((ext_vector_type(8)))short;
using s16x4=__attribute__((ext_vector_type(4)))short;
using f32x16=__attribute__((ext_vector_type(16)))float;
using u32x4=__attribute__((ext_vector_type(4)))unsigned;
constexpr int BATCH=4,NHEAD=16,SEQ=8192,D=64,DM=NHEAD*D;
constexpr int NW=8,QBLK=32,QB=QBLK*NW,KVBLK=64,NQB=SEQ/QB;
constexpr int ATTN_PITCH=DM, ATTN_UNIT_ROWS=QB;
__device__ __forceinline__ int crow(int r,int hi){return (r&3)+8*(r>>2)+4*hi;}
#define SBAR() __builtin_amdgcn_sched_barrier(0)
__device__ __forceinline__ void cmask(f32x16&p0,f32x16&p1,int jb,int qrel,int hi){
  const float NEG=-INFINITY; int kb=64*jb+4*hi;
  #pragma unroll
  for(int r=0;r<16;++r){int kv=kb+(r&3)+8*(r>>2); if(kv>qrel)p0[r]=NEG; if(kv+32>qrel)p1[r]=NEG;}
}

constexpr int NSLOT=3, SLOTB=8192;
constexpr int LDS_K=0, LDS_V=NSLOT*SLOTB, LDS_WS=2*NSLOT*SLOTB, LDS_OST=LDS_WS+NW*64*4, LDS_BYTES=LDS_OST+NW*4096, LDS_STASH=LDS_BYTES, LDS_TOTAL=LDS_STASH+NW*8192;
constexpr float C2=0.125f*1.4426950408889634f;
__device__ __forceinline__ void glds16(const void*gsrc,unsigned lds_dst){unsigned keep;
  asm volatile("s_mov_b32 %0, m0\n\ts_mov_b32 m0, %2\n\ts_nop 0\n\tglobal_load_lds_dwordx4 %1, off\n\ts_mov_b32 m0, %0":"=&s"(keep):"v"(gsrc),"s"(lds_dst):"memory");}
__device__ __forceinline__ float max3f(float a,float b,float c){float r;asm("v_max3_f32 %0, %1, %2, %3":"=v"(r):"v"(a),"v"(b),"v"(c));return r;}
__device__ __forceinline__ float max2f(float a,float b){float r;asm("v_max_f32_e32 %0, %1, %2":"=v"(r):"v"(a),"v"(b));return r;}
__device__ __forceinline__ float fadd_s(float a,float b){float r;asm("v_add_f32_e32 %0, %1, %2":"=v"(r):"v"(a),"v"(b));return r;}
__device__ __forceinline__ float fsub_s(float a,float b){float r;asm("v_sub_f32_e32 %0, %1, %2":"=v"(r):"v"(a),"v"(b));return r;}
typedef float f32x2_t __attribute__((ext_vector_type(2))); typedef __bf16 bf16x2_t __attribute__((ext_vector_type(2)));
__device__ __forceinline__ unsigned cvtpk_s(float lo,float hi){f32x2_t v={lo,hi};bf16x2_t b=__builtin_convertvector(v,bf16x2_t);return __builtin_bit_cast(unsigned,b);}
#define WAIT_BAR(N) asm volatile("s_waitcnt vmcnt(" #N ") lgkmcnt(0)\n\ts_barrier":::"memory")

__device__ __forceinline__ void qkt(f32x16&p0,f32x16&p1,const char*Kslot,const bf16x8*qr,const f32x16&negm,int r32,int hi){
  const char*kb=Kslot+hi*1024+r32*16;
  #pragma unroll
  for(int d0=0;d0<4;++d0){
    const bf16x8 b0=*reinterpret_cast<const bf16x8*>(kb+d0*2048);
    const bf16x8 b1=*reinterpret_cast<const bf16x8*>(kb+d0*2048+512);
    if(d0==0){p0=__builtin_amdgcn_mfma_f32_32x32x16_bf16(b0,qr[0],negm,0,0,0);p1=__builtin_amdgcn_mfma_f32_32x32x16_bf16(b1,qr[0],negm,0,0,0);}
    else{p0=__builtin_amdgcn_mfma_f32_32x32x16_bf16(b0,qr[d0],p0,0,0,0);p1=__builtin_amdgcn_mfma_f32_32x32x16_bf16(b1,qr[d0],p1,0,0,0);}}
}
typedef __attribute__((address_space(3))) const char* lds_cptr;
typedef short v4i16_t __attribute__((ext_vector_type(4)));
__device__ __forceinline__ void kload8(bf16x8*kf,lds_cptr kp){
  kf[0]=*(const __attribute__((address_space(3))) bf16x8*)(kp);      kf[1]=*(const __attribute__((address_space(3))) bf16x8*)(kp+512);
  kf[2]=*(const __attribute__((address_space(3))) bf16x8*)(kp+2048); kf[3]=*(const __attribute__((address_space(3))) bf16x8*)(kp+2560);
  kf[4]=*(const __attribute__((address_space(3))) bf16x8*)(kp+4096); kf[5]=*(const __attribute__((address_space(3))) bf16x8*)(kp+4608);
  kf[6]=*(const __attribute__((address_space(3))) bf16x8*)(kp+6144); kf[7]=*(const __attribute__((address_space(3))) bf16x8*)(kp+6656);
}
__device__ __forceinline__ void kload2(bf16x8*kf,lds_cptr kp,int j){ kf[2*j]=*(const __attribute__((address_space(3))) bf16x8*)(kp+j*2048); kf[2*j+1]=*(const __attribute__((address_space(3))) bf16x8*)(kp+j*2048+512); }
__device__ __forceinline__ s16x4 vtr(lds_cptr p){ return __builtin_bit_cast(s16x4,__builtin_amdgcn_ds_read_tr16_b64_v4i16((__attribute__((address_space(3))) v4i16_t*)p)); }
__device__ __forceinline__ float rowmax(const f32x16&p0,const f32x16&p1){
  float a=max3f(p0[0],p0[1],p1[0]),b=max3f(p0[2],p0[3],p1[1]);a=max3f(a,p1[2],p1[3]);
  #pragma unroll
  for(int r=4;r<16;r+=4){a=max3f(a,p0[r],p0[r+1]);b=max3f(b,p0[r+2],p0[r+3]);a=max3f(a,p1[r],p1[r+1]);b=max3f(b,p1[r+2],p1[r+3]);}
  const float m=max2f(a,b);
  auto rr=__builtin_amdgcn_permlane32_swap(__float_as_uint(m),__float_as_uint(m),false,false);
  return max2f(__uint_as_float(rr[0]),__uint_as_float(rr[1]));
}
__device__ __forceinline__ void pv(f32x16*o,int vb,bf16x8 pa0,bf16x8 pa1,bf16x8 pa2,bf16x8 pa3){
  #pragma unroll
  for(int d0=0;d0<2;++d0){s16x4 lo[4],hi[4];
    #pragma unroll
    for(int ks=0;ks<4;++ks){
      asm volatile("ds_read_b64_tr_b16 %0,%1 offset:%c2":"=&v"(lo[ks]):"v"(vb),"i"(d0*4096+ks*1024):"memory");
      asm volatile("ds_read_b64_tr_b16 %0,%1 offset:%c2":"=&v"(hi[ks]):"v"(vb),"i"(d0*4096+ks*1024+512):"memory");}
    asm volatile("s_waitcnt lgkmcnt(0)":::"memory");SBAR();
    #define PK(k) (bf16x8){lo[k][0],lo[k][1],lo[k][2],lo[k][3],hi[k][0],hi[k][1],hi[k][2],hi[k][3]}
    o[d0]=__builtin_amdgcn_mfma_f32_32x32x16_bf16(pa0,PK(0),o[d0],0,0,0);
    o[d0]=__builtin_amdgcn_mfma_f32_32x32x16_bf16(pa1,PK(1),o[d0],0,0,0);
    o[d0]=__builtin_amdgcn_mfma_f32_32x32x16_bf16(pa2,PK(2),o[d0],0,0,0);
    o[d0]=__builtin_amdgcn_mfma_f32_32x32x16_bf16(pa3,PK(3),o[d0],0,0,0);
    #undef PK
  }
}

#ifndef ATTN_STORE16
#define ATTN_STORE16(p,v) (*(u32x4*)(p)=(v))
#endif
template<int THRL> __device__ __forceinline__ void attn_unit(int b,int h,int hv,int qb,const unsigned char*wsb,char*shm,int mode,float lam){ const bf16*Q=(const bf16*)(wsb+ATT_OFF_Q); const bf16*__restrict__ K=(const bf16*)(wsb+ATT_OFF_K); const bf16*__restrict__ V=(const bf16*)(wsb+ATT_OFF_V);
  int tid=threadIdx.x; asm volatile("":"+v"(tid)); const int lane=tid&63,r32=lane&31,hi=lane>>5; const int wid=__builtin_amdgcn_readfirstlane(tid>>6);
  const long rowbase=(long)b*SEQ; const int q0=qb*QB;
  const bf16*Qw=Q+(rowbase+q0+wid*QBLK)*DM+h*D;
  const bf16*Kh=K+rowbase*DM+h*D,*Vh=V+rowbase*DM+hv*D;
  const unsigned lds0=(unsigned)(uintptr_t)shm;
  float*wsf=(float*)(shm+LDS_WS)+wid*64;
  const bf16*ksrc=Kh+(long)lane*DM+wid*8;
  const bf16*vsrc=Vh+(long)(16*(wid&3)+(lane>>2))*DM+(wid>>2)*32+(lane&3)*8;
  const unsigned kdst=lds0+LDS_K+wid*1024, vdst=lds0+LDS_V+wid*1024;
  #define DMA_K(t,slot) glds16(ksrc+(long)(t)*KVBLK*DM,(unsigned)__builtin_amdgcn_readfirstlane(kdst+(slot)))
  #define DMA_V(t,slot) glds16(vsrc+(long)(t)*KVBLK*DM,(unsigned)__builtin_amdgcn_readfirstlane(vdst+(slot)))
  const int vb0=(int)(lds0+LDS_V)+((lane>>4)&1)*32+(lane&3)*8+(4*hi+((lane&15)>>2))*64;
  const char*Kbase=shm+LDS_K; bf16x8 kf[8];
  const lds_cptr shm3=(lds_cptr)shm; const lds_cptr kp0=shm3+LDS_K+hi*1024+r32*16; const lds_cptr vp0=shm3+LDS_V+((lane>>4)&1)*32+(lane&3)*8+(4*hi+((lane&15)>>2))*64;
  const int NT=(q0+QB)/KVBLK;
  DMA_K(0,0);DMA_V(0,0);DMA_K(1,SLOTB);
  bf16x8 qr[4];
  #pragma unroll
  for(int d0=0;d0<4;++d0)qr[d0]=*reinterpret_cast<const bf16x8*>(&Qw[(long)r32*DM+d0*16+hi*8]);
  float mhat=0.f,l_reg=0.f;f32x16 o[2];o[0]=f32x16{};o[1]=f32x16{};f32x16 negm=f32x16{};asm volatile("":"+v"(negm));
  const int qrel=wid*QBLK+r32;
  #define CMASK(P0,P1,t) do{int jb_=(t)-(NT-4); if(jb_>=0)cmask(P0,P1,jb_,qrel,hi);}while(0)
  bool resc=false;
  #define START(P0,P1) do{ const float rm=rowmax(P0,P1); resc=false; \
    { const float dl=rm; mhat=fadd_s(mhat,dl); \
      _Pragma("unroll") for(int r=0;r<16;++r){P0[r]=fsub_s(P0[r],dl);P1[r]=fsub_s(P1[r],dl);} \
      _Pragma("unroll") for(int r=0;r<16;++r)negm[r]=-mhat; asm volatile("":"+v"(negm)); } \
    _Pragma("unroll") for(int r=0;r<16;++r)P0[r]=__builtin_amdgcn_exp2f(P0[r]); }while(0)
  #define RESC() do{ if(resc){ asm volatile("s_waitcnt lgkmcnt(0)":::"memory"); \
      _Pragma("unroll") for(int d_=0;d_<2;++d_) _Pragma("unroll") for(int r=0;r<16;++r)o[d_][r]*=wsf[crow(r,hi)]; } }while(0)
  f32x16 pA0,pA1,pB0,pB1;
  int sl_prev=0,sl_cur=0,sl_next=SLOTB;
  #define ROT() do{sl_prev=sl_cur;sl_cur=sl_next;sl_next=(sl_next==(NSLOT-1)*SLOTB)?0:sl_next+SLOTB;}while(0)
  DMA_K(2,2*SLOTB);
  WAIT_BAR(3);
  qkt(pA0,pA1,Kbase,qr,negm,r32,hi);asm volatile("s_nop 15\n\ts_nop 7":"+v"(pA0),"+v"(pA1));CMASK(pA0,pA1,0);
  START(pA0,pA1);
  _Pragma("unroll") for(int r=0;r<16;++r)pA1[r]=__builtin_amdgcn_exp2f(pA1[r]);
  WAIT_BAR(0);
  DMA_K(3,0);DMA_V(1,SLOTB);
  ROT();
  kload8(kf,kp0+sl_cur);
  WAIT_BAR(2);
  s16x4 vlo[8],vhi[8]; u32x4 pw0,pw1,pw2,pw3;
  #define PKW(P,B) cvtpk_s(P[B],P[B+1])
  #define PAF(k) __builtin_bit_cast(bf16x8,pw##k)
  #define VFR(i) (bf16x8){vlo[i][0],vlo[i][1],vlo[i][2],vlo[i][3],vhi[i][0],vhi[i][1],vhi[i][2],vhi[i][3]}
  #define PIN(x) asm volatile("":"+v"(x))
  #define MX3(a,b,c) __builtin_fmaxf(__builtin_fmaxf((a),(b)),(c))
  #define GAPA(MF,A0,A1,A2,A3,W0,W1,PW) do{ MF; sacc+=A0; sacc+=A1; sacc+=A2; sacc+=A3; PIN(sacc); W0; W1; PIN(PW); SBAR(); }while(0)
  #define EX(v) __builtin_amdgcn_exp2f(v)
  #define GAPB(MF,X,B) do{ MF; X[B]=EX(X[B]); X[B+1]=EX(X[B+1]); X[B+2]=EX(X[B+2]); X[B+3]=EX(X[B+3]); PIN(X); SBAR(); }while(0)
  #define VRD(i) do{ vlo[i]=vtr(vp_+(((i)>>2)*4096+((i)&3)*1024)); vhi[i]=vtr(vp_+(((i)>>2)*4096+((i)&3)*1024+512)); }while(0)
  #define KRD(G,j) do{ if(G){ kload2(kf,kp0+sl_next,j); SBAR(); } }while(0)
  #define STEP(C0,C1,P0,P1,t,GK,GV,GL) do{ SBAR(); \
    const lds_cptr vp_=vp0+sl_prev; \
    VRD(0); SBAR(); float sacc=(P0[0]+P0[1]); \
    GAPA(C0=__builtin_amdgcn_mfma_f32_32x32x16_bf16(kf[0],qr[0],negm,0,0,0), P0[2],P0[3],P0[4],P0[5],     pw0[0]=PKW(P0,0), pw0[1]=PKW(P0,2), pw0); \
    VRD(4); SBAR(); GAPA(C1=__builtin_amdgcn_mfma_f32_32x32x16_bf16(kf[1],qr[0],negm,0,0,0), P0[6],P0[7],P0[8],P0[9],     pw0[2]=PKW(P0,4), pw0[3]=PKW(P0,6), pw0); \
    VRD(1); SBAR(); GAPA(C0=__builtin_amdgcn_mfma_f32_32x32x16_bf16(kf[2],qr[1],C0,0,0,0),   P0[10],P0[11],P0[12],P0[13], pw1[0]=PKW(P0,8), pw1[1]=PKW(P0,10), pw1); \
    VRD(5); SBAR(); GAPA(C1=__builtin_amdgcn_mfma_f32_32x32x16_bf16(kf[3],qr[1],C1,0,0,0),   P0[14],P0[15],P1[0],P1[1],   pw1[2]=PKW(P0,12),pw1[3]=PKW(P0,14), pw1); \
    VRD(2); SBAR(); GAPA(C0=__builtin_amdgcn_mfma_f32_32x32x16_bf16(kf[4],qr[2],C0,0,0,0),   P1[2],P1[3],P1[4],P1[5],     pw2[0]=PKW(P1,0), pw2[1]=PKW(P1,2), pw2); \
    VRD(6); SBAR(); GAPA(C1=__builtin_amdgcn_mfma_f32_32x32x16_bf16(kf[5],qr[2],C1,0,0,0),   P1[6],P1[7],P1[8],P1[9],     pw2[2]=PKW(P1,4), pw2[3]=PKW(P1,6), pw2); \
    VRD(3); SBAR(); GAPA(C0=__builtin_amdgcn_mfma_f32_32x32x16_bf16(kf[6],qr[3],C0,0,0,0),   P1[10],P1[11],P1[12],P1[13], pw3[0]=PKW(P1,8), pw3[1]=PKW(P1,10), pw3); \
    VRD(7); SBAR(); GAPA(C1=__builtin_amdgcn_mfma_f32_32x32x16_bf16(kf[7],qr[3],C1,0,0,0),   P1[14],P1[15],0.f,0.f,       pw3[2]=PKW(P1,12),pw3[3]=PKW(P1,14), pw3); \
    l_reg+=sacc; \
    if(GK){DMA_K((t)+3,sl_cur);} if(GV){DMA_V((t)+1,sl_next);} \
    CMASK(C0,C1,t); \
    { float a=MX3(C0[0],C0[1],C1[0]),b=MX3(C0[2],C0[3],C1[1]); a=MX3(a,C1[2],C1[3]); \
      _Pragma("unroll") for(int r=4;r<16;r+=4){a=MX3(a,C0[r],C0[r+1]);b=MX3(b,C0[r+2],C0[r+3]);a=MX3(a,C1[r],C1[r+1]);b=MX3(b,C1[r+2],C1[r+3]);} \
      float rm=__builtin_fmaxf(a,b); { auto rr=__builtin_amdgcn_permlane32_swap(__float_as_uint(rm),__float_as_uint(rm),false,false); rm=__builtin_fmaxf(__uint_as_float(rr[0]),__uint_as_float(rr[1])); } \
      resc=false; \
      if(__builtin_expect(__any(rm>(float)THRL),0)){ const float dl=__builtin_fmaxf(rm,0.f); mhat+=dl; \
        _Pragma("unroll") for(int r=0;r<16;++r){C0[r]-=dl;C1[r]-=dl;} \
        _Pragma("unroll") for(int r=0;r<16;++r)negm[r]=-mhat; asm volatile("":"+v"(negm)); \
        const float f=__builtin_amdgcn_exp2f(-dl); l_reg*=f; if(hi==0)wsf[r32]=f; resc=true; } } \
    SBAR(); \
    GAPB(o[0]=__builtin_amdgcn_mfma_f32_32x32x16_bf16(PAF(0),VFR(0),o[0],0,0,0), C0,0); \
    GAPB(o[1]=__builtin_amdgcn_mfma_f32_32x32x16_bf16(PAF(0),VFR(4),o[1],0,0,0), C0,4); \
    KRD(GL,0); GAPB(o[0]=__builtin_amdgcn_mfma_f32_32x32x16_bf16(PAF(1),VFR(1),o[0],0,0,0), C0,8); \
    KRD(GL,1); GAPB(o[1]=__builtin_amdgcn_mfma_f32_32x32x16_bf16(PAF(1),VFR(5),o[1],0,0,0), C0,12); \
    KRD(GL,2); GAPB(o[0]=__builtin_amdgcn_mfma_f32_32x32x16_bf16(PAF(2),VFR(2),o[0],0,0,0), C1,0); \
    KRD(GL,3); GAPB(o[1]=__builtin_amdgcn_mfma_f32_32x32x16_bf16(PAF(2),VFR(6),o[1],0,0,0), C1,4); \
    GAPB(o[0]=__builtin_amdgcn_mfma_f32_32x32x16_bf16(PAF(3),VFR(3),o[0],0,0,0), C1,8); \
    GAPB(o[1]=__builtin_amdgcn_mfma_f32_32x32x16_bf16(PAF(3),VFR(7),o[1],0,0,0), C1,12); \
    }while(0)
  int t=1;
  #undef CMASK
  #define CMASK(P0,P1,t) do{}while(0)
  for(;t+5<NT;t+=2){
    STEP(pB0,pB1,pA0,pA1,t,true,true,true);     WAIT_BAR(2); RESC(); ROT();
    STEP(pA0,pA1,pB0,pB1,t+1,true,true,true);   WAIT_BAR(2); RESC(); ROT();
  }
  #undef CMASK
  #define CMASK(P0,P1,t) do{int jb_=(t)-(NT-4); if(jb_>=0)cmask(P0,P1,jb_,qrel,hi);}while(0)
  #define ENDW(tt) do{ if((tt)+3<NT){WAIT_BAR(2);} else if((tt)+2<NT){WAIT_BAR(1);} else {WAIT_BAR(0);} }while(0)
  for(;t+1<NT;t+=2){
    STEP(pB0,pB1,pA0,pA1,t,(t+3<NT),(t+1<NT),(t+1<NT));       ENDW(t);   RESC(); ROT();
    STEP(pA0,pA1,pB0,pB1,t+1,(t+4<NT),(t+2<NT),(t+2<NT));     ENDW(t+1); RESC(); ROT();
  }
  STEP(pB0,pB1,pA0,pA1,NT-1,false,false,false); RESC();
  { float sacc=pB0[0]+pB0[1]; _Pragma("unroll") for(int r=2;r<16;++r)sacc+=pB0[r]; _Pragma("unroll") for(int r=0;r<16;++r)sacc+=pB1[r]; l_reg+=sacc;
    pw0=(u32x4){PKW(pB0,0),PKW(pB0,2),PKW(pB0,4),PKW(pB0,6)};pw1=(u32x4){PKW(pB0,8),PKW(pB0,10),PKW(pB0,12),PKW(pB0,14)};pw2=(u32x4){PKW(pB1,0),PKW(pB1,2),PKW(pB1,4),PKW(pB1,6)};pw3=(u32x4){PKW(pB1,8),PKW(pB1,10),PKW(pB1,12),PKW(pB1,14)};
    SBAR(); pv(o,vb0+sl_cur,PAF(0),PAF(1),PAF(2),PAF(3)); }
  #undef PKW
  #undef PAF
  #undef VFR
  #undef PIN
  #undef MX3
  #undef GAPA
  #undef GAPB
  #undef EX
  #undef VRD
  #undef KRD
  #undef STEP
  #undef ENDW
  {auto rr=__builtin_amdgcn_permlane32_swap(__float_as_uint(l_reg),__float_as_uint(l_reg),false,false);l_reg=__uint_as_float(rr[0])+__uint_as_float(rr[1]);}
  if(hi==0)wsf[32+r32]=l_reg;asm volatile("s_waitcnt lgkmcnt(0)":::"memory");
  float rli[16];
  #pragma unroll
  for(int r=0;r<16;++r)rli[r]=__builtin_amdgcn_rcpf(wsf[32+crow(r,hi)]);
  float*stash=(float*)(shm+LDS_STASH)+wid*2048;
  if(mode==0){
    #pragma unroll
    for(int r=0;r<16;++r){
      #pragma unroll
      for(int d0=0;d0<2;++d0)stash[(d0*16+r)*64+lane]=o[d0][r]*rli[r];}
  }else{
    bf16*O=(bf16*)(const_cast<unsigned char*>(wsb)+ATT_OFF_O); float*ssq=(float*)(const_cast<unsigned char*>(wsb)+ATT_OFF_SSQ);
    bf16*Ow=O+(rowbase+q0+wid*QBLK)*DM+hv*D;
    bf16*stg=(bf16*)(shm+LDS_OST)+wid*2048;
    #pragma unroll
    for(int r=0;r<16;++r){const int orow=crow(r,hi);
      #pragma unroll
      for(int d0=0;d0<2;++d0){const float dv=stash[(d0*16+r)*64+lane]-lam*(o[d0][r]*rli[r]); stg[orow*64+d0*32+r32]=__float2bfloat16(dv);}}
    asm volatile("s_waitcnt lgkmcnt(0)":::"memory");
    #pragma unroll
    for(int i=0;i<4;++i){const int row=i*8+(lane>>3),ch=lane&7; const u32x4 v=*(const u32x4*)(stg+row*64+ch*8);
      float s=0.f;
      #pragma unroll
      for(int w=0;w<4;++w){const float lo_=__uint_as_float(v[w]<<16),hi_=__uint_as_float(v[w]&0xffff0000u); s+=lo_*lo_+hi_*hi_;}
      s+=__shfl_xor(s,1);s+=__shfl_xor(s,2);s+=__shfl_xor(s,4);
      if(ch==0)ssq[(rowbase+q0+wid*QBLK+row)*16+hv]=s;
      ATTN_STORE16(Ow+(long)row*DM+ch*8,v);}
  }
  asm volatile("s_waitcnt lgkmcnt(0)\n\ts_barrier":::"memory");
  #undef DMA_K
  #undef DMA_V
  #undef CMASK
  #undef START
  #undef RESC
  #undef ROT
}
constexpr int ATTN_LDS_BYTES=LDS_BYTES;
#undef SBAR
#undef WAIT_BAR
}

#include <hip/hip_cooperative_groups.h>
namespace cg = cooperative_groups;
#define LAS __attribute__((address_space(3)))
typedef unsigned short bf16;
typedef unsigned v4u __attribute__((ext_vector_type(4)));
typedef float f32x4 __attribute__((ext_vector_type(4)));
typedef short bf16x8 __attribute__((ext_vector_type(8)));
typedef float f32x16 __attribute__((ext_vector_type(16)));
typedef short s16x4 __attribute__((ext_vector_type(4)));

constexpr int NB = 4, SEQ = 8192, M = NB * SEQ, DM = 1024, DEPTH = 4, INW = 6656, DFF = 2816, NMOD = 6 * DM;
constexpr float C2 = 0.125f * 1.4426950408889634f;
constexpr float LOG2E = 1.4426950408889634f;
constexpr size_t MiB = 1u << 20;
constexpr size_t WS_MOD = 512 * 1024;
constexpr size_t WS_ROPE = 1 * MiB;
constexpr size_t WS_SSQ = 9 * MiB;
constexpr size_t WS_WIN = 11 * MiB;
constexpr size_t WS_WA = 24 * MiB, WS_WB = 26 * MiB, WS_WO = 28 * MiB;
constexpr size_t WS_H = 30 * MiB;
constexpr size_t WS_PROJ = 94 * MiB;
constexpr size_t WS_QA = WS_PROJ, WS_KA = WS_QA + 64 * MiB, WS_VA = WS_KA + 64 * MiB, WS_QS = WS_VA + 64 * MiB, WS_KS = WS_QS + 64 * MiB, WS_VS = WS_KS + 16 * MiB, WS_GATES = WS_VS + 16 * MiB;
constexpr size_t WS_GU = WS_PROJ;
constexpr size_t WS_MIXED = WS_KA;
constexpr size_t WS_WGU = WS_PROJ + 352 * MiB;
constexpr size_t WS_WD = WS_WGU + 11 * MiB;
constexpr size_t WS_END = WS_GATES + 128 * MiB;
static_assert(WS_END == 510 * MiB && WS_WD + (size_t)DM * DFF * 2 <= WS_END && WS_GU + (size_t)M * 2 * DFF * 2 <= WS_WGU, "ws map");
constexpr int LDS_BYTES = 155648;

struct Params { const float* in[20]; float* out; unsigned char* ws; };

__device__ __forceinline__ int opaque_tid() { int t = threadIdx.x; asm volatile("" : "+v"(t)); return t; }
template <class T> __device__ __forceinline__ T* opaque_ptr(T* q) {
    unsigned lo = (unsigned)(unsigned long long)q, hi = (unsigned)((unsigned long long)q >> 32);
    asm volatile("" : "+v"(lo), "+v"(hi));
    lo = __builtin_amdgcn_readfirstlane(lo); hi = __builtin_amdgcn_readfirstlane(hi);
    return (T*)(((unsigned long long)hi << 32) | lo); }
__device__ __forceinline__ const float* inptr(const Params& p, int k) { asm volatile("" : "+s"(k)); return p.in[k]; }
static_assert(WS_QA == ATT_OFF_Q && WS_KA == ATT_OFF_K && WS_VA == ATT_OFF_V && WS_H == ATT_OFF_O && WS_SSQ == ATT_OFF_SSQ, "attention workspace offsets");

__device__ __forceinline__ unsigned f2bf(float f) { unsigned u = __builtin_bit_cast(unsigned, f); return (u + 0x7fffu + ((u >> 16) & 1u)) >> 16; }
__device__ __forceinline__ unsigned pk2(float lo, float hi) { typedef float f2 __attribute__((ext_vector_type(2))); typedef __bf16 b2 __attribute__((ext_vector_type(2))); f2 v = {lo, hi}; b2 b = __builtin_convertvector(v, b2); return __builtin_bit_cast(unsigned, b); }
__device__ __forceinline__ float bflo(unsigned w) { return __uint_as_float(w << 16); }
__device__ __forceinline__ float bfhi(unsigned w) { return __uint_as_float(w & 0xffff0000u); }
__device__ __forceinline__ float wave_sum(float v) {
#pragma unroll
    for (int o = 1; o < 64; o <<= 1) v += __shfl_xor(v, o);
    return v;
}
__device__ __forceinline__ float fast_sigmoid(float x) { return __builtin_amdgcn_rcpf(1.0f + __builtin_amdgcn_exp2f(-x * LOG2E)); }
__device__ __forceinline__ float fast_silu(float x) { return x * fast_sigmoid(x); }
__device__ __forceinline__ float lambda_init_of(int l) { return l == 0 ? 0.2f : l == 1 ? 0.35550906759096926f : l == 2 ? 0.47071301834358413f : 0.5560582041564726f; }

struct EpiIn {
    static constexpr bool PERM = true, AFTER_DRAIN = false;
    unsigned char* ws; const float* rope;
    __device__ __forceinline__ void operator()(const pg8::f32x4 (&acc)[2][2][4][2], const pg8::Unit& u, int wr, int wc, int fr, int fq) const {
        const int pn = u.pn; bf16* base; int ld, kind;
        if (pn < 4)        { base = (bf16*)(ws + WS_QA) + pn * 256;        ld = 1024; kind = 0; }
        else if (pn < 8)   { base = (bf16*)(ws + WS_KA) + (pn - 4) * 256;  ld = 1024; kind = 1; }
        else if (pn < 12)  { base = (bf16*)(ws + WS_VA) + (pn - 8) * 256;  ld = 1024; kind = 2; }
        else if (pn < 16)  { base = (bf16*)(ws + WS_QS) + (pn - 12) * 256; ld = 1024; kind = 0; }
        else if (pn == 16) { base = (bf16*)(ws + WS_KS);                   ld = 256;  kind = 1; }
        else if (pn == 17) { base = (bf16*)(ws + WS_VS);                   ld = 256;  kind = 2; }
        else               { base = (bf16*)(ws + WS_GATES) + (pn - 18) * 256; ld = 2048; kind = 3; }
        const int row0 = u.pm * 256 + wr * 64 + fr, colp = 64 * wc + 8 * fq;
#pragma unroll
        for (int ai = 0; ai < 2; ++ai)
#pragma unroll
            for (int m = 0; m < 4; ++m) {
                const int row = row0 + ai * 128 + m * 16;
                pg8::f32x4 a0 = acc[ai][0][m][0], a1 = acc[ai][0][m][1], b0 = acc[ai][1][m][0], b1 = acc[ai][1][m][1];
                if (kind <= 1) {
                    const float* rp = rope + (size_t)row * 64 + 8 * fq;
                    const pg8::f32x4 c0 = *(const pg8::f32x4*)rp, c1 = *(const pg8::f32x4*)(rp + 4), s0 = *(const pg8::f32x4*)(rp + 32), s1 = *(const pg8::f32x4*)(rp + 36);
                    const pg8::f32x4 o1a = a0 * c0 - b0 * s0, o1b = a1 * c1 - b1 * s1, o2a = b0 * c0 + a0 * s0, o2b = b1 * c1 + a1 * s1;
                    const float sc = (kind == 0) ? C2 : 1.0f;
                    a0 = o1a * sc; a1 = o1b * sc; b0 = o2a * sc; b1 = o2b * sc;
                } else if (kind == 3) {
#pragma unroll
                    for (int i = 0; i < 4; ++i) { a0[i] = fast_sigmoid(a0[i]); a1[i] = fast_sigmoid(a1[i]); b0[i] = fast_sigmoid(b0[i]); b1[i] = fast_sigmoid(b1[i]); }
                }
                pg8::u32x4 w1, w2;
                w1.x = pk2(a0[0], a0[1]); w1.y = pk2(a0[2], a0[3]); w1.z = pk2(a1[0], a1[1]); w1.w = pk2(a1[2], a1[3]);
                w2.x = pk2(b0[0], b0[1]); w2.y = pk2(b0[2], b0[3]); w2.z = pk2(b1[0], b1[1]); w2.w = pk2(b1[2], b1[3]);
                bf16* rowp = base + (size_t)row * ld + colp;
                *(pg8::u32x4*)rowp = w1; *(pg8::u32x4*)(rowp + 32) = w2;
            }
    }
};
struct EpiBranch {
    static constexpr bool PERM = true, AFTER_DRAIN = false;
    const bf16* gates; bf16* mixed;
    __device__ __forceinline__ void operator()(const pg8::f32x4 (&acc)[2][2][4][2], const pg8::Unit& u, int wr, int wc, int fr, int fq) const {
        const int row0 = u.pm * 256 + wr * 64 + fr, col0 = u.pn * 256 + wc * 32 + 8 * fq, br = u.br;
#pragma unroll
        for (int ai = 0; ai < 2; ++ai)
#pragma unroll
            for (int m = 0; m < 4; ++m) {
                const int row = row0 + ai * 128 + m * 16;
#pragma unroll
                for (int bj = 0; bj < 2; ++bj) {
                    const int col = col0 + bj * 128;
                    const pg8::u32x4 gv = *(const pg8::u32x4*)(gates + (size_t)row * 2048 + br * 1024 + col);
                    const pg8::f32x4 v0 = acc[ai][bj][m][0], v1 = acc[ai][bj][m][1];
                    float r[8];
                    r[0] = bflo(gv.x) * v0[0]; r[1] = bfhi(gv.x) * v0[1]; r[2] = bflo(gv.y) * v0[2]; r[3] = bfhi(gv.y) * v0[3];
                    r[4] = bflo(gv.z) * v1[0]; r[5] = bfhi(gv.z) * v1[1]; r[6] = bflo(gv.w) * v1[2]; r[7] = bfhi(gv.w) * v1[3];
                    bf16* mp = mixed + (size_t)row * 1024 + col;
                    if (br) { const pg8::u32x4 t = *(const pg8::u32x4*)mp;
                        r[0] += bflo(t.x); r[1] += bfhi(t.x); r[2] += bflo(t.y); r[3] += bfhi(t.y); r[4] += bflo(t.z); r[5] += bfhi(t.z); r[6] += bflo(t.w); r[7] += bfhi(t.w); }
                    pg8::u32x4 w; w.x = pk2(r[0], r[1]); w.y = pk2(r[2], r[3]); w.z = pk2(r[4], r[5]); w.w = pk2(r[6], r[7]);
                    *(pg8::u32x4*)mp = w;
                }
            }
    }
};
struct EpiResid {
    static constexpr bool PERM = false, AFTER_DRAIN = false;
    const float* xin; float* xout; const float* gate;
    __device__ __forceinline__ void operator()(const pg8::f32x4 (&acc)[2][2][4][2], const pg8::Unit& u, int wr, int wc, int fr, int fq) const {
        const int b = (u.pm * 256) / SEQ; const float* gv = gate + (size_t)b * NMOD;
        const int row0 = u.pm * 256 + wr * 64 + fr, col0 = u.pn * 256 + wc * 32 + 4 * fq;
#pragma unroll
        for (int bj = 0; bj < 2; ++bj)
#pragma unroll
            for (int n = 0; n < 2; ++n) {
                const int col = col0 + bj * 128 + n * 16;
                const pg8::f32x4 g = *(const pg8::f32x4*)(gv + col);
#pragma unroll
                for (int ai = 0; ai < 2; ++ai)
#pragma unroll
                    for (int m = 0; m < 4; ++m) {
                        const size_t off = (size_t)(row0 + ai * 128 + m * 16) * DM + col;
                        const pg8::f32x4 xi = *(const pg8::f32x4*)(xin + off);
                        *(pg8::f32x4*)(xout + off) = xi + g * acc[ai][bj][m][n];
                    }
            }
    }
};
struct BranchOrder {
    pg8::StaticOrder S;
    __device__ __forceinline__ bool next(int i, pg8::Unit& u) const { if (!S.next(i >> 1, u)) return false; u.br = i & 1; return true; }
    __device__ __forceinline__ void a_ready(const pg8::Unit&) const {}
    __device__ __forceinline__ void done(const pg8::Unit&) const {}
};

__device__ __forceinline__ void transpose_item(const float* W, int K, int N, bf16* WT, int row_off, bool perm, LAS float* scr, int item, int lane) {
    const int nblk = N / 32, kb = item / nblk, nb = item % nblk, k0 = 64 * kb, n0 = 32 * nb;
#pragma unroll 8
    for (int i = 0; i < 32; ++i) { const int kk = 2 * i + (lane >> 5); scr[kk * 33 + (lane & 31)] = W[(size_t)(k0 + kk) * N + n0 + (lane & 31)]; }
    asm volatile("s_waitcnt lgkmcnt(0)" ::: "memory");
    const int d0 = perm ? ((n0 & ~255) + 128 * ((n0 >> 5) & 1) + 32 * ((n0 >> 6) & 3)) : n0;
    const int c = lane & 7;
#pragma unroll
    for (int j = 0; j < 4; ++j) { const int n = (lane >> 3) + 8 * j; const LAS float* s = scr + (8 * c) * 33 + n;
        v4u o; o.x = pk2(s[0 * 33], s[1 * 33]); o.y = pk2(s[2 * 33], s[3 * 33]); o.z = pk2(s[4 * 33], s[5 * 33]); o.w = pk2(s[6 * 33], s[7 * 33]);
        *(v4u*)(WT + (size_t)(row_off + d0 + n) * K + k0 + 8 * c) = o; }
    asm volatile("s_waitcnt lgkmcnt(0)" ::: "memory");
}
__device__ __forceinline__ void rms_row_to_bf16(const float* xrow, bf16* orow, const float* gn, const float* sc, const float* sh, int lane) {
    const f32x4* xr = (const f32x4*)xrow + lane;
    f32x4 v[4]; float s = 0.f;
#pragma unroll
    for (int j = 0; j < 4; ++j) { v[j] = xr[64 * j]; s += (v[j].x * v[j].x + v[j].y * v[j].y) + (v[j].z * v[j].z + v[j].w * v[j].w); }
    const float rstd = 1.0f / sqrtf(wave_sum(s) * (1.f / DM) + 1e-6f);
    unsigned long long* o8 = (unsigned long long*)orow + lane;
#pragma unroll
    for (int j = 0; j < 4; ++j) {
        const f32x4 g = ((const f32x4*)gn)[lane + 64 * j], c = ((const f32x4*)sc)[lane + 64 * j], h = ((const f32x4*)sh)[lane + 64 * j];
        const f32x4 y = (v[j] * rstd) * g * (c + 1.0f) + h;
        o8[64 * j] = (unsigned long long)pk2(y.x, y.y) | ((unsigned long long)pk2(y.z, y.w) << 32);
    }
}
__device__ __forceinline__ void sincos_acc(float ang, float& sn, float& cs) {
    const double a = (double)ang;
    const double kf = __builtin_rint(a * 0.6366197723675814);
    double r = __builtin_fma(-kf, 1.5707963267948966, a); r = __builtin_fma(-kf, 6.123233995736766e-17, r);
    const double r2 = r * r;
    double sp = -1.0 / 6227020800.0 * 0.0 + 1.0 / 6227020800.0;
    sp = sp * r2 - 1.0 / 39916800.0; sp = sp * r2 + 1.0 / 362880.0; sp = sp * r2 - 1.0 / 5040.0; sp = sp * r2 + 1.0 / 120.0; sp = sp * r2 - 1.0 / 6.0; sp = sp * r2 + 1.0;
    const double s = sp * r;
    double cp = 1.0 / 479001600.0;
    cp = cp * r2 - 1.0 / 3628800.0; cp = cp * r2 + 1.0 / 40320.0; cp = cp * r2 - 1.0 / 720.0; cp = cp * r2 + 1.0 / 24.0; cp = cp * r2 - 0.5; cp = cp * r2 + 1.0;
    const int q = ((int)kf) & 3;
    const double ss = (q == 0) ? s : (q == 1) ? cp : (q == 2) ? -s : -cp;
    const double cc = (q == 0) ? cp : (q == 1) ? -s : (q == 2) ? -cp : s;
    sn = (float)ss; cs = (float)cc;
}

constexpr int SWA_KP = 144, SWA_VP = 528;
__device__ __forceinline__ void swa_unit(int b, int kvh, int qblk, bf16* Qs, const bf16* Ks, const bf16* Vs, const float* sinks, LAS unsigned char* lds) {
    const int tid = opaque_tid(), lane = tid & 63, r32 = lane & 31, hi = lane >> 5; const int wid = __builtin_amdgcn_readfirstlane(tid >> 6);
    const long rowbase = (long)b * SEQ; const int q0 = qblk * 128, kv0 = q0 - 128;
    LAS unsigned char* Kl = lds; LAS unsigned char* Vt = lds + 256 * SWA_KP;
#pragma unroll
    for (int i = 0; i < 4; ++i) {
        const int ch = tid + 512 * i, row = ch >> 3, c8 = ch & 7, kabs = kv0 + row;
        v4u kv = {0u, 0u, 0u, 0u}, vv = {0u, 0u, 0u, 0u};
        if (kabs >= 0) { kv = *(const v4u*)(Ks + (size_t)(rowbase + kabs) * 256 + kvh * 64 + c8 * 8); vv = *(const v4u*)(Vs + (size_t)(rowbase + kabs) * 256 + kvh * 64 + c8 * 8); }
        *(LAS v4u*)(Kl + row * SWA_KP + c8 * 16) = kv;
#pragma unroll
        for (int j = 0; j < 4; ++j) { const unsigned w = vv[j];
            *(LAS unsigned short*)(Vt + (c8 * 8 + 2 * j) * SWA_VP + row * 2) = (unsigned short)(w & 0xffffu);
            *(LAS unsigned short*)(Vt + (c8 * 8 + 2 * j + 1) * SWA_VP + row * 2) = (unsigned short)(w >> 16); }
    }
    __syncthreads();
#pragma unroll 1
    for (int tt = 0; tt < 2; ++tt) {
        const int task = wid * 2 + tt, g = task >> 2, t = task & 3, qh = kvh * 4 + g;
        bf16* qp = Qs + (size_t)(rowbase + q0 + 32 * t + r32) * 1024 + qh * 64 + hi * 8;
        bf16x8 qr[4];
#pragma unroll
        for (int d0 = 0; d0 < 4; ++d0) qr[d0] = *(const bf16x8*)(qp + d0 * 16);
        const float sink2 = sinks[qh] * LOG2E;
        f32x16 p[5];
#pragma unroll
        for (int jt = 0; jt < 5; ++jt) {
            const LAS unsigned char* kb = Kl + ((t + jt) * 32 + r32) * SWA_KP + hi * 16;
            f32x16 a = {};
#pragma unroll
            for (int d0 = 0; d0 < 4; ++d0) { const bf16x8 kf = *(const LAS bf16x8*)(kb + d0 * 32); a = __builtin_amdgcn_mfma_f32_32x32x16_bf16(kf, qr[d0], a, 0, 0, 0); }
            p[jt] = a;
        }
        float mx = sink2;
#pragma unroll
        for (int jt = 0; jt < 5; ++jt)
#pragma unroll
            for (int i = 0; i < 16; ++i) {
                const int cr = (i & 3) + 8 * (i >> 2) + 4 * hi, dlt = 128 + r32 - 32 * jt - cr, kabs = kv0 + (t + jt) * 32 + cr;
                const bool vis = (dlt >= 0) && (dlt < 128) && (kabs >= 0);
                p[jt][i] = vis ? p[jt][i] : -INFINITY; mx = fmaxf(mx, p[jt][i]);
            }
        mx = fmaxf(mx, __shfl_xor(mx, 32));
        float sum = 0.f;
#pragma unroll
        for (int jt = 0; jt < 5; ++jt)
#pragma unroll
            for (int i = 0; i < 16; ++i) { const float e = __builtin_amdgcn_exp2f(p[jt][i] - mx); p[jt][i] = e; sum += e; }
        sum += __shfl_xor(sum, 32);
        const float linv = 1.0f / (sum + __builtin_amdgcn_exp2f(sink2 - mx));
        f32x16 o[2]; o[0] = f32x16{}; o[1] = f32x16{};
#pragma unroll
        for (int jt = 0; jt < 5; ++jt)
#pragma unroll
            for (int s = 0; s < 2; ++s) {
                v4u pw; pw.x = pk2(p[jt][8 * s], p[jt][8 * s + 1]); pw.y = pk2(p[jt][8 * s + 2], p[jt][8 * s + 3]); pw.z = pk2(p[jt][8 * s + 4], p[jt][8 * s + 5]); pw.w = pk2(p[jt][8 * s + 6], p[jt][8 * s + 7]);
                const bf16x8 pa = __builtin_bit_cast(bf16x8, pw);
#pragma unroll
                for (int d0 = 0; d0 < 2; ++d0) {
                    const LAS unsigned char* vp = Vt + (d0 * 32 + r32) * SWA_VP + ((t + jt) * 32 + 16 * s + 4 * hi) * 2;
                    const s16x4 lo = *(const LAS s16x4*)vp, h4 = *(const LAS s16x4*)(vp + 16);
                    const bf16x8 vb = __builtin_shufflevector(lo, h4, 0, 1, 2, 3, 4, 5, 6, 7);
                    o[d0] = __builtin_amdgcn_mfma_f32_32x32x16_bf16(pa, vb, o[d0], 0, 0, 0);
                }
            }
        bf16* op = Qs + (size_t)(rowbase + q0 + 32 * t) * 1024 + qh * 64 + r32;
#pragma unroll
        for (int i = 0; i < 16; ++i) {
            const int cr = (i & 3) + 8 * (i >> 2) + 4 * hi; const float li = __shfl(linv, cr);
            op[(size_t)cr * 1024] = (bf16)f2bf(o[0][i] * li); op[(size_t)cr * 1024 + 32] = (bf16)f2bf(o[1][i] * li);
        }
    }
    __syncthreads();
}

#define PH_TID() const int tid = opaque_tid(), lane = tid & 63, wave = __builtin_amdgcn_readfirstlane(tid >> 6); (void)lane; (void)wave; \
    const int gw = vcu * 8 + wave, NGW = G * 8; (void)gw; (void)NGW; unsigned char* ws = opaque_ptr(p.ws); (void)ws
__global__ void __launch_bounds__(512, 2) fwd_megakernel(Params p) {
    extern __shared__ __attribute__((aligned(16))) unsigned char lds_raw[];
    cg::grid_group grid = cg::this_grid();
    LAS unsigned char* lds = (LAS unsigned char*)lds_raw;
    const int G = gridDim.x, bx = blockIdx.x;
    const int vcu = (G % 8 == 0) ? (bx % 8) * (G / 8) + bx / 8 : bx;

#ifndef SKIP_P0
    {
        const int tid = threadIdx.x, lane = tid & 63, wave = __builtin_amdgcn_readfirstlane(tid >> 6); unsigned char* ws = p.ws;
        const float* c_in = p.in[1]; const int* pos = (const int*)p.in[2]; const float* w_ada = p.in[3]; const float* b_ada = p.in[4];
        float* mod = (float*)(ws + WS_MOD); float* rope = (float*)(ws + WS_ROPE);
#ifndef SKIP_ROPE
        for (int e0 = bx * 512; e0 < M * 32; e0 += G * 512) {
            const int e = e0 + tid; const int row = e >> 5, i = e & 31;
            const float inv_freq = (float)exp2(-(double)(2 * i) * (13.287712379549449 / 64.0));
            const float ang = (float)pos[row] * inv_freq;
            float sn, cs; sincos_acc(ang, sn, cs);
            rope[(size_t)row * 64 + i] = cs; rope[(size_t)row * 64 + 32 + i] = sn;
        }
#endif
#ifndef SKIP_MOD
        {
            LAS float* cact = (LAS float*)lds;
            LAS float* red = (LAS float*)(lds + 16384);
            for (int e = tid; e < NB * DM; e += 512) cact[e] = fast_silu(c_in[e]);
            __syncthreads();
            for (int unit = bx; unit < DEPTH * 96; unit += G) {
                const int l = unit / 96, col = (unit % 96) * 64 + lane;
                const float* Wp = w_ada + (size_t)l * DM * NMOD + (size_t)(wave * 128) * NMOD + col;
                float a0 = 0.f, a1 = 0.f, a2 = 0.f, a3 = 0.f;
#pragma unroll 8
                for (int kk = 0; kk < 128; ++kk) { const float w = Wp[(size_t)kk * NMOD]; const int k = wave * 128 + kk;
                    a0 += cact[k] * w; a1 += cact[1024 + k] * w; a2 += cact[2048 + k] * w; a3 += cact[3072 + k] * w; }
                red[(wave * 4 + 0) * 64 + lane] = a0; red[(wave * 4 + 1) * 64 + lane] = a1; red[(wave * 4 + 2) * 64 + lane] = a2; red[(wave * 4 + 3) * 64 + lane] = a3;
                __syncthreads();
                if (wave < 4) { float s = b_ada[(size_t)l * NMOD + col];
#pragma unroll
                    for (int w = 0; w < 8; ++w) s += red[(w * 4 + wave) * 64 + lane];
                    mod[(size_t)(l * NB + wave) * NMOD + col] = s; }
                __syncthreads();
            }
        }
#endif
    }
#endif
    grid.sync();

#pragma unroll 1
    for (int l = 0; l < DEPTH; ++l) {
#ifndef SKIP_P1
        {
            PH_TID();
            LAS float* scr = (LAS float*)(lds + wave * 16384);
            const float* xcur = (l == 0) ? inptr(p, 0) : (const float*)opaque_ptr(p.out);
            const float* modl = (const float*)(ws + WS_MOD) + (size_t)l * NB * NMOD;
            const float* w_in = inptr(p, 6); const float* w_ba = inptr(p, 10); const float* w_bb = inptr(p, 11); const float* w_out = inptr(p, 12); const float* attn_norm = inptr(p, 5);
            constexpr int I_IN = 16 * (INW / 32), I_SQ = 16 * 32;
            for (int it = gw; it < I_IN + 3 * I_SQ; it += NGW) {
                int r = it;
                if (r < I_IN) { transpose_item(w_in + (size_t)l * DM * INW, DM, INW, (bf16*)(ws + WS_WIN), 0, true, scr, r, lane); continue; } r -= I_IN;
                if (r < I_SQ) { transpose_item(w_ba + (size_t)l * DM * DM, DM, DM, (bf16*)(ws + WS_WA), 0, false, scr, r, lane); continue; } r -= I_SQ;
                if (r < I_SQ) { transpose_item(w_bb + (size_t)l * DM * DM, DM, DM, (bf16*)(ws + WS_WB), 0, false, scr, r, lane); continue; } r -= I_SQ;
                transpose_item(w_out + (size_t)l * DM * DM, DM, DM, (bf16*)(ws + WS_WO), 0, false, scr, r, lane);
            }
            bf16* H = (bf16*)(ws + WS_H);
            for (int m = gw; m < M; m += NGW) { const float* mb = modl + (size_t)(m / SEQ) * NMOD;
                rms_row_to_bf16(xcur + (size_t)m * DM, H + (size_t)m * DM, attn_norm + l * DM, mb + 1024, mb, lane); }
        }
#endif
        grid.sync();
#ifndef SKIP_P2
        {
            unsigned char* ws = opaque_ptr(p.ws);
            pg8::Gemm g{(const bf16*)(ws + WS_H), (const bf16*)(ws + WS_WIN), DM, DM, DM, 0, 0}; pg8::StaticOrder S; S.init(M, INW, G, bx);
            EpiIn E{ws, (const float*)(ws + WS_ROPE)};
            pg8::gemm_phase<EpiIn, pg8::StaticOrder, PG8_ALIGN, PG8_SP2>(lds, g, S, E);
        }
#endif
        grid.sync();
#ifndef SKIP_P3
        {
#ifndef SKIP_ATTN
            float lam;
            { const int ln = opaque_tid() & 63; const float* lq = inptr(p, 7) + l * 256;
              const float s1 = wave_sum(lq[ln] * lq[64 + ln]), s2 = wave_sum(lq[128 + ln] * lq[192 + ln]);
              lam = __uint_as_float(__builtin_amdgcn_readfirstlane(__float_as_uint(expf(s1) - expf(s2) + lambda_init_of(l)))); }
            for (int it = vcu; it < 1024; it += G) {
                const int combo = it >> 4, pr = it & 15, b = combo >> 4, h = (combo >> 1) & 7, vh = combo & 1;
#pragma unroll 1
                for (int k = 0; k < 2; ++k) {
                    const int qb = k ? 31 - pr : pr;
#pragma unroll 1
                    for (int c = 0; c < 2; ++c)
                        attn_body::attn_unit<8>(b, 2 * h + c, 2 * h + vh, qb, opaque_ptr(p.ws), (char*)lds_raw, c, lam);
                }
            }
#endif
#ifndef SKIP_SWA
            { const float* sinks = inptr(p, 9) + l * 16;
              for (int u = vcu; u < 1024; u += G) { unsigned char* ws = opaque_ptr(p.ws); swa_unit(u >> 8, (u >> 6) & 3, u & 63, (bf16*)(ws + WS_QS), (const bf16*)(ws + WS_KS), (const bf16*)(ws + WS_VS), sinks, lds); } }
#endif
        }
#endif
        grid.sync();
#ifndef SKIP_P4
        {
            PH_TID();
            const float* ssq = (const float*)(ws + WS_SSQ); const bf16* H = (const bf16*)(ws + WS_H); bf16* QA = (bf16*)(ws + WS_QA);
            const float* subln = inptr(p, 8); const float lam_init = lambda_init_of(l);
            for (int m = gw; m < M; m += NGW) {
                const int head = lane >> 3, e0 = (lane & 7) * 16;
                const float ss = ssq[(size_t)m * 16 + 2 * head] + ssq[(size_t)m * 16 + 2 * head + 1];
                const float rs = (1.0f / sqrtf(ss * (1.f / 128.f) + 1e-5f)) * (1.0f - lam_init);
                const v4u d0 = *(const v4u*)(H + (size_t)m * DM + lane * 16), d1 = *(const v4u*)(H + (size_t)m * DM + lane * 16 + 8);
                const float* gp = subln + l * 128 + e0;
                v4u o0, o1;
                o0.x = pk2(bflo(d0.x) * rs * gp[0], bfhi(d0.x) * rs * gp[1]); o0.y = pk2(bflo(d0.y) * rs * gp[2], bfhi(d0.y) * rs * gp[3]);
                o0.z = pk2(bflo(d0.z) * rs * gp[4], bfhi(d0.z) * rs * gp[5]); o0.w = pk2(bflo(d0.w) * rs * gp[6], bfhi(d0.w) * rs * gp[7]);
                o1.x = pk2(bflo(d1.x) * rs * gp[8], bfhi(d1.x) * rs * gp[9]); o1.y = pk2(bflo(d1.y) * rs * gp[10], bfhi(d1.y) * rs * gp[11]);
                o1.z = pk2(bflo(d1.z) * rs * gp[12], bfhi(d1.z) * rs * gp[13]); o1.w = pk2(bflo(d1.w) * rs * gp[14], bfhi(d1.w) * rs * gp[15]);
                *(v4u*)(QA + (size_t)m * DM + lane * 16) = o0; *(v4u*)(QA + (size_t)m * DM + lane * 16 + 8) = o1;
            }
        }
#endif
        grid.sync();
#ifndef SKIP_P5
        {
            unsigned char* ws = opaque_ptr(p.ws);
            pg8::Gemm g{(const bf16*)(ws + WS_QA), (const bf16*)(ws + WS_WA), DM, DM, DM, (size_t)(WS_QS - WS_QA), (size_t)(WS_WB - WS_WA)}; BranchOrder S; S.S.init(M, DM, G, bx);
            EpiBranch E{(const bf16*)(ws + WS_GATES), (bf16*)(ws + WS_MIXED)};
            pg8::gemm_phase<EpiBranch, BranchOrder, PG8_ALIGN, PG8_SP2>(lds, g, S, E);
        }
#endif
        grid.sync();
#ifndef SKIP_P6
        {
            unsigned char* ws = opaque_ptr(p.ws);
            float* out = (float*)opaque_ptr(p.out);
            const float* xcur = (l == 0) ? inptr(p, 0) : (const float*)out;
            pg8::Gemm g{(const bf16*)(ws + WS_MIXED), (const bf16*)(ws + WS_WO), DM, DM, DM, 0, 0}; pg8::StaticOrder S; S.init(M, DM, G, bx);
            EpiResid E{xcur, out, (const float*)(ws + WS_MOD) + (size_t)l * NB * NMOD + 2048};
            pg8::gemm_phase<EpiResid, pg8::StaticOrder, PG8_ALIGN, PG8_SP2>(lds, g, S, E);
        }
#endif
        grid.sync();
#ifndef SKIP_P7
        {
            PH_TID();
            LAS float* scr = (LAS float*)(lds + wave * 16384);
            const float* out = (const float*)opaque_ptr(p.out);
            const float* modl = (const float*)(ws + WS_MOD) + (size_t)l * NB * NMOD;
            const float* w_gate = inptr(p, 14); const float* w_up = inptr(p, 15); const float* w_down = inptr(p, 18); const float* ffn_norm = inptr(p, 13);
            constexpr int I_G = 16 * (DFF / 32), I_D = (DFF / 64) * 32;
            for (int it = gw; it < 2 * I_G + I_D; it += NGW) {
                int r = it;
                if (r < I_G) { transpose_item(w_gate + (size_t)l * DM * DFF, DM, DFF, (bf16*)(ws + WS_WGU), 0, false, scr, r, lane); continue; } r -= I_G;
                if (r < I_G) { transpose_item(w_up + (size_t)l * DM * DFF, DM, DFF, (bf16*)(ws + WS_WGU), DFF, false, scr, r, lane); continue; } r -= I_G;
                transpose_item(w_down + (size_t)l * DFF * DM, DFF, DM, (bf16*)(ws + WS_WD), 0, false, scr, r, lane);
            }
            bf16* H = (bf16*)(ws + WS_H);
            for (int m = gw; m < M; m += NGW) { const float* mb = modl + (size_t)(m / SEQ) * NMOD;
                rms_row_to_bf16(out + (size_t)m * DM, H + (size_t)m * DM, ffn_norm + l * DM, mb + 4096, mb + 3072, lane); }
        }
#endif
        grid.sync();
#ifndef SKIP_P8
        {
            unsigned char* ws = opaque_ptr(p.ws);
            pg8::Gemm g{(const bf16*)(ws + WS_H), (const bf16*)(ws + WS_WGU), DM, DM, DM, 0, 0}; pg8::StaticOrder S; S.init(M, 2 * DFF, G, bx);
            pg8::EpiBf16<0> E{(bf16*)(ws + WS_GU), 2 * DFF, nullptr, 0, 0, 1.f};
            pg8::gemm_phase<pg8::EpiBf16<0>, pg8::StaticOrder, PG8_ALIGN, PG8_SP2>(lds, g, S, E);
        }
#endif
        grid.sync();
#ifndef SKIP_P9
        {
            PH_TID();
            bf16* GU = (bf16*)(ws + WS_GU); const float* conv_w = inptr(p, 16); const float* conv_b = inptr(p, 17);
            for (int item = bx; item < M / 64; item += G) {
                if (tid < DFF / 8) {
                    const int col = tid * 8, r0 = item * 64;
                    float cw0[8], cw1[8], cw2[8], cb[8], gm2[8], gm1[8];
#pragma unroll
                    for (int j = 0; j < 8; ++j) { cw0[j] = conv_w[(size_t)(l * 3 + 0) * DFF + col + j]; cw1[j] = conv_w[(size_t)(l * 3 + 1) * DFF + col + j]; cw2[j] = conv_w[(size_t)(l * 3 + 2) * DFF + col + j];
                        cb[j] = conv_b[(size_t)l * DFF + col + j]; gm2[j] = 0.f; gm1[j] = 0.f; }
                    if ((r0 % SEQ) != 0) {
                        const v4u a = *(const v4u*)(GU + (size_t)(r0 - 2) * (2 * DFF) + col), bq = *(const v4u*)(GU + (size_t)(r0 - 1) * (2 * DFF) + col);
                        gm2[0] = bflo(a.x); gm2[1] = bfhi(a.x); gm2[2] = bflo(a.y); gm2[3] = bfhi(a.y); gm2[4] = bflo(a.z); gm2[5] = bfhi(a.z); gm2[6] = bflo(a.w); gm2[7] = bfhi(a.w);
                        gm1[0] = bflo(bq.x); gm1[1] = bfhi(bq.x); gm1[2] = bflo(bq.y); gm1[3] = bfhi(bq.y); gm1[4] = bflo(bq.z); gm1[5] = bfhi(bq.z); gm1[6] = bflo(bq.w); gm1[7] = bfhi(bq.w);
                    }
#pragma unroll 4
                    for (int r = 0; r < 64; ++r) {
                        bf16* gp = GU + (size_t)(r0 + r) * (2 * DFF) + col;
                        const v4u gv = *(const v4u*)gp, uv = *(const v4u*)(gp + DFF);
                        float gq[8], uq[8], a[8];
                        gq[0] = bflo(gv.x); gq[1] = bfhi(gv.x); gq[2] = bflo(gv.y); gq[3] = bfhi(gv.y); gq[4] = bflo(gv.z); gq[5] = bfhi(gv.z); gq[6] = bflo(gv.w); gq[7] = bfhi(gv.w);
                        uq[0] = bflo(uv.x); uq[1] = bfhi(uv.x); uq[2] = bflo(uv.y); uq[3] = bfhi(uv.y); uq[4] = bflo(uv.z); uq[5] = bfhi(uv.z); uq[6] = bflo(uv.w); uq[7] = bfhi(uv.w);
#pragma unroll
                        for (int j = 0; j < 8; ++j) { const float gc = cb[j] + cw0[j] * gm2[j] + cw1[j] * gm1[j] + cw2[j] * gq[j]; a[j] = fast_silu(gc) * uq[j]; gm2[j] = gm1[j]; gm1[j] = gq[j]; }
                        v4u o; o.x = pk2(a[0], a[1]); o.y = pk2(a[2], a[3]); o.z = pk2(a[4], a[5]); o.w = pk2(a[6], a[7]);
                        *(v4u*)(gp + DFF) = o;
                    }
                }
            }
        }
#endif
        grid.sync();
#ifndef SKIP_P10
        {
            unsigned char* ws = opaque_ptr(p.ws);
            float* out = (float*)opaque_ptr(p.out);
            pg8::Gemm g{(const bf16*)(ws + WS_GU) + DFF, (const bf16*)(ws + WS_WD), 2 * DFF, DFF, DFF, 0, 0}; pg8::StaticOrder S; S.init(M, DM, G, bx);
            EpiResid E{out, out, (const float*)(ws + WS_MOD) + (size_t)l * NB * NMOD + 5120};
            pg8::gemm_phase<EpiResid, pg8::StaticOrder, PG8_ALIGN, PG8_SP2>(lds, g, S, E);
        }
#endif
        grid.sync();
    }
    {
        PH_TID();
        float* out = (float*)opaque_ptr(p.out); const float* final_norm = inptr(p, 19);
        for (int m = gw; m < M; m += NGW) {
            f32x4* xr = (f32x4*)(out + (size_t)m * DM) + lane;
            f32x4 v[4]; float s = 0.f;
#pragma unroll
            for (int j = 0; j < 4; ++j) { v[j] = xr[64 * j]; s += (v[j].x * v[j].x + v[j].y * v[j].y) + (v[j].z * v[j].z + v[j].w * v[j].w); }
            const float rstd = 1.0f / sqrtf(wave_sum(s) * (1.f / DM) + 1e-6f);
#pragma unroll
            for (int j = 0; j < 4; ++j) xr[64 * j] = (v[j] * rstd) * ((const f32x4*)final_norm)[lane + 64 * j];
        }
    }
}

extern "C" void kernel_launch(void* const* d_in, const int* in_sizes, int n_in, void* d_out, int out_size, void* d_ws, size_t ws_size, hipStream_t stream) {
    static int grid_blocks = 0;
    if (grid_blocks == 0) {
        if (n_in != 20 || ws_size < WS_END || out_size != M * DM) { fprintf(stderr, "kernel_launch: unexpected problem (n_in %d, ws %zu, out %d)\n", n_in, ws_size, out_size); grid_blocks = -1; return; }
        int dev = 0, cus = 0, per_cu = 0;
        hipGetDevice(&dev);
        hipDeviceGetAttribute(&cus, hipDeviceAttributeMultiprocessorCount, dev);
        hipFuncSetAttribute((const void*)fwd_megakernel, hipFuncAttributeMaxDynamicSharedMemorySize, LDS_BYTES);
        hipOccupancyMaxActiveBlocksPerMultiprocessor(&per_cu, (const void*)fwd_megakernel, 512, LDS_BYTES);
        if (per_cu < 1) per_cu = 1;
        grid_blocks = cus * per_cu;
        (void)hipGetLastError();
    }
    if (grid_blocks < 0) return;
    Params p{};
    for (int i = 0; i < 20; ++i) p.in[i] = (const float*)d_in[i];
    p.out = (float*)d_out; p.ws = (unsigned char*)d_ws;
    void* args[] = {&p};
    hipError_t e = hipLaunchCooperativeKernel((const void*)fwd_megakernel, dim3(grid_blocks), dim3(512), args, LDS_BYTES, stream);
    if (e != hipSuccess) fprintf(stderr, "cooperative launch failed: %s (grid %d)\n", hipGetErrorString(e), grid_blocks);
}
```

```cpp
#include <hip/hip_runtime.h>
#include <cstdio>
#include <cstdint>
namespace pg8 {
#define PG8_LAS __attribute__((address_space(3)))
typedef unsigned short bf16_t;
typedef short bf16x8 __attribute__((ext_vector_type(8)));
typedef float f32x4 __attribute__((ext_vector_type(4)));
typedef unsigned u32x4 __attribute__((ext_vector_type(4)));
constexpr int BM = 256, BK = 64, HALF = 128, HTB = HALF * BK * 2  , STAGE_BYTES = 8 * HTB, NXCD = 8, WGM = 8;

__host__ __device__ __forceinline__ int lds_byte(int r, int c) { const int st = (r >> 4) * 2 + (c >> 5), rr = r & 15, cc = c & 31, ob = rr * 64 + cc * 2; return st * 1024 + (ob ^ (((ob >> 9) & 1) << 5)); }
__host__ __device__ __forceinline__ void stage_rc(int b, int& R, int& C) { const int st = b / 1024, sb = b % 1024, swz = sb ^ (((sb >> 9) & 1) << 5); R = (st >> 1) * 16 + swz / 64; C = (st & 1) * 32 + (swz % 64) / 2; }
__host__ __device__ __forceinline__ int perm32(int rho) { const int n = rho >> 4, i = rho & 15; return 8 * (i >> 2) + 4 * n + (i & 3); }

struct Unit { int pm, pn, br; };
struct Gemm { const bf16_t* A; const bf16_t* Bt; int lda, ldb, K; size_t abr, bbr; };

struct StaticOrder {
    int nM, nN, nwg, G, c;
    __host__ __device__ void init(int M, int N, int G_, int c_) { nM = M / BM; nN = N / BM; nwg = nM * nN; G = G_; c = c_; }
    __host__ __device__ bool next(int i, Unit& u) const {
        const long L = (long)i * G + c; if (L >= nwg) return false;
        int wgid = (int)L; { const int q = nwg / NXCD, r = nwg % NXCD, xcd = wgid % NXCD, off = wgid / NXCD; wgid = (xcd < r ? xcd * (q + 1) : r * (q + 1) + (xcd - r) * q) + off; }
        const int nig = WGM * nN, gid = wgid / nig, fm = gid * WGM, gsz = (nM - fm) < WGM ? (nM - fm) : WGM;
        u.pm = fm + ((wgid % nig) % gsz); u.pn = (wgid % nig) / gsz; u.br = 0; return true;
    }
    __device__ __forceinline__ void a_ready(const Unit&) const {}
    __device__ __forceinline__ void done(const Unit&) const {}
};

__device__ __forceinline__ unsigned cvt_pk_bf16(float lo, float hi) { unsigned r; asm volatile("v_cvt_pk_bf16_f32 %0, %1, %2" : "=v"(r) : "v"(lo), "v"(hi)); return r; }
typedef float f32x2 __attribute__((ext_vector_type(2)));
__device__ __forceinline__ f32x2 gelu_pk(f32x2 v) {
    const f32x2 av = __builtin_elementwise_abs(v), d = av * 0.2316418882f + 1.0f;
    f32x2 t; t.x = __builtin_amdgcn_rcpf(d.x); t.y = __builtin_amdgcn_rcpf(d.y);
    f32x2 q = t * 0.5307027145f + (-0.7265760135f); q = q * t + 0.7107068705f; q = q * t + (-0.142248368f); q = q * t + 0.127414796f; q = q * t;
    const f32x2 s = (v * v) * (-0.72134752044f);
    f32x2 e; e.x = __builtin_amdgcn_exp2f(s.x); e.y = __builtin_amdgcn_exp2f(s.y);
    const f32x2 m = v * (q * e), r = v - m;
    f32x2 o; o.x = v.x < 0.f ? m.x : r.x; o.y = v.y < 0.f ? m.y : r.y; return o;
}

template <int ACT  > struct EpiBf16 {
    static constexpr bool PERM = true, AFTER_DRAIN = false; static_assert(ACT == 0 || ACT == 1, "EpiBf16: ACT is 0 (none) or 1 (gelu_pk)");
    bf16_t* O; int ldc; const float* bias; int split_cols; size_t split_stride; float scale0;
    __device__ __forceinline__ void operator()(const f32x4 (&acc)[2][2][4][2], const Unit& u, int wr, int wc, int fr, int fq) const {
        const int row0 = u.pm * BM + wr * 64 + fr; int colt = u.pn * BM; bf16_t* base = O;
        float sc = 1.f; if (split_cols) { const int t = colt / split_cols; base += (size_t)t * split_stride; colt -= t * split_cols; if (t == 0) sc = scale0; }
        const int col0 = colt + wc * 32 + 8 * fq, bcol0 = u.pn * BM + wc * 32 + 8 * fq;
        f32x4 bv[2][2];
#pragma unroll
        for (int bj = 0; bj < 2; ++bj)
#pragma unroll
            for (int n = 0; n < 2; ++n) bv[bj][n] = bias ? *(const f32x4*)(bias + bcol0 + bj * HALF + 4 * n) : (f32x4){0.f, 0.f, 0.f, 0.f};
#pragma unroll
        for (int ai = 0; ai < 2; ++ai)
#pragma unroll
            for (int m = 0; m < 4; ++m) { bf16_t* rowp = base + (size_t)(row0 + ai * HALF + m * 16) * ldc + col0;
#pragma unroll
                for (int bj = 0; bj < 2; ++bj) { f32x4 v0 = acc[ai][bj][m][0] + bv[bj][0], v1 = acc[ai][bj][m][1] + bv[bj][1];
                    if (ACT == 1) { f32x2 a = gelu_pk((f32x2){v0[0], v0[1]}), b = gelu_pk((f32x2){v0[2], v0[3]}), c = gelu_pk((f32x2){v1[0], v1[1]}), d = gelu_pk((f32x2){v1[2], v1[3]});
                        v0 = (f32x4){a.x, a.y, b.x, b.y}; v1 = (f32x4){c.x, c.y, d.x, d.y}; }
                    v0 = v0 * sc; v1 = v1 * sc; u32x4 w; w.x = cvt_pk_bf16(v0[0], v0[1]); w.y = cvt_pk_bf16(v0[2], v0[3]); w.z = cvt_pk_bf16(v1[0], v1[1]); w.w = cvt_pk_bf16(v1[2], v1[3]);
                    *(u32x4*)(rowp + bj * HALF) = w; } }
    }
};
template <class Epi, class Sched, bool ALIGN_EPI = false, bool SP2 = false>
__device__ __forceinline__ void gemm_phase(PG8_LAS unsigned char* lds, const Gemm g, const Sched& S, const Epi& E) {
    int tid_ = threadIdx.x; asm volatile("" : "+v"(tid_)); const int tid = tid_, wid = __builtin_amdgcn_readfirstlane(tid >> 6), lane = tid & 63, wr = wid >> 2, wc = wid & 3, fr = lane & 15, fq = lane >> 4;
    const int K = g.K, nt = K / BK;
    unsigned voffA[2], voffB[2];
#pragma unroll
    for (int i = 0; i < 2; ++i) { int R, C; stage_rc(tid * 16 + i * 8192, R, C); const int Rb = Epi::PERM ? ((R & ~31) + perm32(R & 31)) : R;
        voffA[i] = (unsigned)(R * g.lda + C) * 2u; voffB[i] = (unsigned)(Rb * g.ldb + C) * 2u; }
    const size_t kstep = (size_t)(BK * 2);
    const size_t hstepA = (size_t)HALF * g.lda * 2, hstepB = (size_t)HALF * g.ldb * 2;
    const size_t tstepA = 2 * hstepA, tstepB = 2 * hstepB;
    const unsigned ldsw = (unsigned)wid * 1024u;
    const int aoff = lds_byte(wr * 64 + fr, fq * 8), boff = lds_byte(wc * 32 + fr, fq * 8);
#define PG8_SA(b, h) (((b) * 2 + (h)) * HTB)
#define PG8_SB(b, h) ((4 + (b) * 2 + (h)) * HTB)
#define PG8_STAGE(bufoff, gbase, voff) do { _Pragma("unroll") for (int _i = 0; _i < 2; ++_i) \
        __builtin_amdgcn_global_load_lds((const unsigned*)((const char*)(gbase) + (voff)[_i]), (PG8_LAS unsigned*)(lds + (bufoff) + ldsw + _i * 8192), 16, 0, 0); } while (0)
#define PG8_LDA(dst, b, h) do { _Pragma("unroll") for (int m = 0; m < 4; ++m) _Pragma("unroll") for (int k = 0; k < 2; ++k) dst[m][k] = *(const PG8_LAS bf16x8*)(lds + PG8_SA(b, h) + aoff + m * 2048 + k * 1024); } while (0)
#define PG8_LDB(dst, b, h) do { _Pragma("unroll") for (int n = 0; n < 2; ++n) _Pragma("unroll") for (int k = 0; k < 2; ++k) dst[n][k] = *(const PG8_LAS bf16x8*)(lds + PG8_SB(b, h) + boff + n * 2048 + k * 1024); } while (0)
#define PG8_MMA(ai, bj, At, Bt) do { __builtin_amdgcn_s_setprio(1); _Pragma("unroll") for (int m = 0; m < 4; ++m) _Pragma("unroll") for (int n = 0; n < 2; ++n) _Pragma("unroll") for (int k = 0; k < 2; ++k) \
        acc[ai][bj][m][n] = __builtin_amdgcn_mfma_f32_16x16x32_bf16(Bt[n][k], At[m][k], acc[ai][bj][m][n], 0, 0, 0); __builtin_amdgcn_s_setprio(0); } while (0)
#define PG8_WAIT_V(n) asm volatile("s_waitcnt vmcnt(" #n ")" ::: "memory")
#define PG8_WAIT_L(n) asm volatile("s_waitcnt lgkmcnt(" #n ")" ::: "memory")
#define PG8_BAR __builtin_amdgcn_s_barrier()
#define PG8_SCHED __builtin_amdgcn_sched_barrier(0)
    Unit cur, nxt; int ui = 0;
    if (!S.next(0, cur)) return;
    f32x4 acc[2][2][4][2];
#pragma unroll
    for (int a = 0; a < 2; ++a)
#pragma unroll
        for (int b = 0; b < 2; ++b)
#pragma unroll
            for (int m = 0; m < 4; ++m)
#pragma unroll
                for (int n = 0; n < 2; ++n) acc[a][b][m][n] = (f32x4){0.f, 0.f, 0.f, 0.f};
    bf16x8 At[4][2], B0[2][2], B1[2][2];
    const char* cA = (const char*)g.A + (size_t)cur.pm * tstepA + (size_t)cur.br * g.abr; const char* cB = (const char*)g.Bt + (size_t)cur.pn * tstepB + (size_t)cur.br * g.bbr;
    S.a_ready(cur);
    if constexpr (SP2) {
        PG8_STAGE(PG8_SB(0, 0), cB, voffB); PG8_STAGE(PG8_SB(0, 1), cB + hstepB, voffB); PG8_STAGE(PG8_SA(0, 0), cA, voffA); PG8_STAGE(PG8_SA(0, 1), cA + hstepA, voffA);
        if (wr == 1) PG8_BAR;
        PG8_WAIT_V(2); PG8_BAR;
        PG8_STAGE(PG8_SB(1, 0), cB + kstep, voffB); PG8_STAGE(PG8_SA(1, 0), cA + kstep, voffA); PG8_STAGE(PG8_SB(1, 1), cB + hstepB + kstep, voffB);
        PG8_WAIT_V(6); PG8_BAR;
    } else {
        PG8_STAGE(PG8_SB(0, 0), cB, voffB); PG8_STAGE(PG8_SA(0, 0), cA, voffA); PG8_STAGE(PG8_SB(0, 1), cB + hstepB, voffB); PG8_STAGE(PG8_SA(0, 1), cA + hstepA, voffA);
        if (wr == 1) PG8_BAR;
        PG8_WAIT_V(4); PG8_BAR;
        PG8_STAGE(PG8_SB(1, 0), cB + kstep, voffB); PG8_STAGE(PG8_SA(1, 0), cA + kstep, voffA); PG8_STAGE(PG8_SB(1, 1), cB + hstepB + kstep, voffB);
        PG8_WAIT_V(6); PG8_BAR;
    }
    for (;;) {
        const bool has_next = S.next(ui + 1, nxt);
        const char* nA = has_next ? (const char*)g.A + (size_t)nxt.pm * tstepA + (size_t)nxt.br * g.abr : cA; const char* nB = has_next ? (const char*)g.Bt + (size_t)nxt.pn * tstepB + (size_t)nxt.br * g.bbr : cB;
        for (int t = 0; t < nt; t += 2) {
            const bool last = (t == nt - 2);
            const char* a1 = cA + (size_t)(t + 1) * kstep;
            const char* a2 = last ? nA : cA + (size_t)(t + 2) * kstep; const char* b2 = last ? nB : cB + (size_t)(t + 2) * kstep;
            const char* a3 = a2 + kstep; const char* b3 = b2 + kstep;
            if (last && has_next) S.a_ready(nxt);
            if constexpr (SP2) {
            PG8_LDB(B0, 0, 0); PG8_LDB(B1, 0, 1); PG8_SCHED; PG8_LDA(At, 0, 0); PG8_STAGE(PG8_SA(1, 1), a1 + hstepA, voffA);
            PG8_WAIT_V(8); PG8_WAIT_L(0); PG8_BAR; PG8_MMA(0, 0, At, B0); PG8_MMA(0, 1, At, B1); PG8_BAR; PG8_SCHED;
            PG8_LDA(At, 0, 1); PG8_STAGE(PG8_SB(0, 0), b2, voffB); PG8_STAGE(PG8_SB(0, 1), b2 + hstepB, voffB); PG8_STAGE(PG8_SA(0, 0), a2, voffA);
            PG8_WAIT_V(8); PG8_WAIT_L(0); PG8_BAR; PG8_MMA(1, 0, At, B0); PG8_MMA(1, 1, At, B1); PG8_BAR; PG8_SCHED;
            PG8_LDB(B0, 1, 0); PG8_LDB(B1, 1, 1); PG8_SCHED; PG8_LDA(At, 1, 0); PG8_STAGE(PG8_SA(0, 1), a2 + hstepA, voffA);
            PG8_WAIT_V(8); PG8_WAIT_L(0); PG8_BAR; PG8_MMA(0, 0, At, B0); PG8_MMA(0, 1, At, B1); PG8_BAR; PG8_SCHED;
            PG8_LDA(At, 1, 1); PG8_STAGE(PG8_SB(1, 0), b3, voffB); PG8_STAGE(PG8_SB(1, 1), b3 + hstepB, voffB); PG8_STAGE(PG8_SA(1, 0), a3, voffA);
            PG8_WAIT_V(8); PG8_WAIT_L(0); PG8_BAR; PG8_MMA(1, 0, At, B0); PG8_MMA(1, 1, At, B1); PG8_BAR; PG8_SCHED;
            } else {
            PG8_LDB(B0, 0, 0); PG8_SCHED; PG8_LDA(At, 0, 0); PG8_STAGE(PG8_SA(1, 1), a1 + hstepA, voffA);
            PG8_WAIT_L(8); PG8_BAR; PG8_WAIT_L(0); PG8_MMA(0, 0, At, B0); PG8_BAR; PG8_SCHED;
            PG8_LDB(B1, 0, 1); PG8_STAGE(PG8_SB(0, 0), b2, voffB);
            PG8_BAR; PG8_WAIT_L(0); PG8_MMA(0, 1, At, B1); PG8_BAR;
            PG8_LDA(At, 0, 1); PG8_STAGE(PG8_SA(0, 0), a2, voffA);
            PG8_BAR; PG8_WAIT_L(0); PG8_MMA(1, 0, At, B0); PG8_BAR; PG8_SCHED;
            PG8_STAGE(PG8_SB(0, 1), b2 + hstepB, voffB);
            PG8_WAIT_V(6); PG8_BAR; PG8_MMA(1, 1, At, B1); PG8_BAR;
            PG8_LDB(B0, 1, 0); PG8_SCHED; PG8_LDA(At, 1, 0); PG8_STAGE(PG8_SA(0, 1), a2 + hstepA, voffA);
            PG8_WAIT_L(8); PG8_BAR; PG8_WAIT_L(0); PG8_MMA(0, 0, At, B0); PG8_BAR; PG8_SCHED;
            PG8_LDB(B1, 1, 1); PG8_STAGE(PG8_SB(1, 0), b3, voffB);
            PG8_BAR; PG8_WAIT_L(0); PG8_MMA(0, 1, At, B1); PG8_BAR;
            PG8_LDA(At, 1, 1); PG8_STAGE(PG8_SA(1, 0), a3, voffA);
            PG8_BAR; PG8_WAIT_L(0); PG8_MMA(1, 0, At, B0); PG8_BAR; PG8_SCHED;
            PG8_STAGE(PG8_SB(1, 1), b3 + hstepB, voffB);
            PG8_WAIT_V(6); PG8_BAR; PG8_MMA(1, 1, At, B1); PG8_BAR;
            }
        }
        if constexpr (ALIGN_EPI) { if (wr == 0) PG8_BAR; }
        if constexpr (!Epi::AFTER_DRAIN) { E(acc, cur, wr, wc, fr, fq); S.done(cur); }
        if (!has_next) break;
#pragma unroll
        for (int a = 0; a < 2; ++a)
#pragma unroll
            for (int b = 0; b < 2; ++b)
#pragma unroll
                for (int m = 0; m < 4; ++m)
#pragma unroll
                    for (int n = 0; n < 2; ++n) acc[a][b][m][n] = (f32x4){0.f, 0.f, 0.f, 0.f};
        cur = nxt; cA = nA; cB = nB; ++ui;
        if constexpr (ALIGN_EPI) { if (wr == 1) PG8_BAR; }
    }
    PG8_WAIT_V(0);
    if constexpr (!ALIGN_EPI) { if (wr == 0) PG8_BAR; }
    PG8_BAR;
    if constexpr (Epi::AFTER_DRAIN) { E.fused(acc, cur, wr, wc, fr, fq, lds, wid, lane); S.done(cur); }
#undef PG8_SA
#undef PG8_SB
#undef PG8_STAGE
#undef PG8_LDA
#undef PG8_LDB
#undef PG8_MMA
#undef PG8_WAIT_V
#undef PG8_WAIT_L
#undef PG8_BAR
#undef PG8_SCHED
}
}

#define PG8_SP2 true
#define PG8_ALIGN true

#define ATT_OFF_Q (94ull<<20)
#define ATT_OFF_K (158ull<<20)
#define ATT_OFF_V (222ull<<20)
#define ATT_OFF_O (30ull<<20)
#define ATT_OFF_SSQ (9ull<<20)
#include <hip/hip_bf16.h>
#include <cmath>
namespace attn_body {
using bf16=__hip_bfloat16;
using bf16x8=__attribute__((ext_vector_type(8)))short;
using s16x4=__attribute__((ext_vector_type(4)))short;
using f32x16=__attribute__((ext_vector_type(16)))float;
using u32x4=__attribute__((ext_vector_type(4)))unsigned;
constexpr int BATCH=4,NHEAD=16,SEQ=8192,D=64,DM=NHEAD*D;
constexpr int NW=8,QBLK=32,QB=QBLK*NW,KVBLK=64,NQB=SEQ/QB;
constexpr int ATTN_PITCH=DM, ATTN_UNIT_ROWS=QB;
__device__ __forceinline__ int crow(int r,int hi){return (r&3)+8*(r>>2)+4*hi;}
#define SBAR() __builtin_amdgcn_sched_barrier(0)
__device__ __forceinline__ void cmask(f32x16&p0,f32x16&p1,int jb,int qrel,int hi){
  const float NEG=-INFINITY; int kb=64*jb+4*hi;
  #pragma unroll
  for(int r=0;r<16;++r){int kv=kb+(r&3)+8*(r>>2); if(kv>qrel)p0[r]=NEG; if(kv+32>qrel)p1[r]=NEG;}
}

constexpr int NSLOT=3, SLOTB=8192;
constexpr int LDS_K=0, LDS_V=NSLOT*SLOTB, LDS_WS=2*NSLOT*SLOTB, LDS_OST=LDS_WS+NW*64*4, LDS_BYTES=LDS_OST+NW*4096, LDS_STASH=LDS_BYTES, LDS_TOTAL=LDS_STASH+NW*8192;
constexpr float C2=0.125f*1.4426950408889634f;
__device__ __forceinline__ void glds16(const void*gsrc,unsigned lds_dst){unsigned keep;
  asm volatile("s_mov_b32 %0, m0\n\ts_mov_b32 m0, %2\n\ts_nop 0\n\tglobal_load_lds_dwordx4 %1, off\n\ts_mov_b32 m0, %0":"=&s"(keep):"v"(gsrc),"s"(lds_dst):"memory");}
__device__ __forceinline__ float max3f(float a,float b,float c){float r;asm("v_max3_f32 %0, %1, %2, %3":"=v"(r):"v"(a),"v"(b),"v"(c));return r;}
__device__ __forceinline__ float max2f(float a,float b){float r;asm("v_max_f32_e32 %0, %1, %2":"=v"(r):"v"(a),"v"(b));return r;}
__device__ __forceinline__ float fadd_s(float a,float b){float r;asm("v_add_f32_e32 %0, %1, %2":"=v"(r):"v"(a),"v"(b));return r;}
__device__ __forceinline__ float fsub_s(float a,float b){float r;asm("v_sub_f32_e32 %0, %1, %2":"=v"(r):"v"(a),"v"(b));return r;}
typedef float f32x2_t __attribute__((ext_vector_type(2))); typedef __bf16 bf16x2_t __attribute__((ext_vector_type(2)));
__device__ __forceinline__ unsigned cvtpk_s(float lo,float hi){f32x2_t v={lo,hi};bf16x2_t b=__builtin_convertvector(v,bf16x2_t);return __builtin_bit_cast(unsigned,b);}
#define WAIT_BAR(N) asm volatile("s_waitcnt vmcnt(" #N ") lgkmcnt(0)\n\ts_barrier":::"memory")

__device__ __forceinline__ void qkt(f32x16&p0,f32x16&p1,const char*Kslot,const bf16x8*qr,const f32x16&negm,int r32,int hi){
  const char*kb=Kslot+hi*1024+r32*16;
  #pragma unroll
  for(int d0=0;d0<4;++d0){
    const bf16x8 b0=*reinterpret_cast<const bf16x8*>(kb+d0*2048);
    const bf16x8 b1=*reinterpret_cast<const bf16x8*>(kb+d0*2048+512);
    if(d0==0){p0=__builtin_amdgcn_mfma_f32_32x32x16_bf16(b0,qr[0],negm,0,0,0);p1=__builtin_amdgcn_mfma_f32_32x32x16_bf16(b1,qr[0],negm,0,0,0);}
    else{p0=__builtin_amdgcn_mfma_f32_32x32x16_bf16(b0,qr[d0],p0,0,0,0);p1=__builtin_amdgcn_mfma_f32_32x32x16_bf16(b1,qr[d0],p1,0,0,0);}}
}
typedef __attribute__((address_space(3))) const char* lds_cptr;
typedef short v4i16_t __attribute__((ext_vector_type(4)));
__device__ __forceinline__ void kload8(bf16x8*kf,lds_cptr kp){
  kf[0]=*(const __attribute__((address_space(3))) bf16x8*)(kp);      kf[1]=*(const __attribute__((address_space(3))) bf16x8*)(kp+512);
  kf[2]=*(const __attribute__((address_space(3))) bf16x8*)(kp+2048); kf[3]=*(const __attribute__((address_space(3))) bf16x8*)(kp+2560);
  kf[4]=*(const __attribute__((address_space(3))) bf16x8*)(kp+4096); kf[5]=*(const __attribute__((address_space(3))) bf16x8*)(kp+4608);
  kf[6]=*(const __attribute__((address_space(3))) bf16x8*)(kp+6144); kf[7]=*(const __attribute__((address_space(3))) bf16x8*)(kp+6656);
}
__device__ __forceinline__ void kload2(bf16x8*kf,lds_cptr kp,int j){ kf[2*j]=*(const __attribute__((address_space(3))) bf16x8*)(kp+j*2048); kf[2*j+1]=*(const __attribute__((address_space(3))) bf16x8*)(kp+j*2048+512); }
__device__ __forceinline__ s16x4 vtr(lds_cptr p){ return __builtin_bit_cast(s16x4,__builtin_amdgcn_ds_read_tr16_b64_v4i16((__attribute__((address_space(3))) v4i16_t*)p)); }
__device__ __forceinline__ float rowmax(const f32x16&p0,const f32x16&p1){
  float a=max3f(p0[0],p0[1],p1[0]),b=max3f(p0[2],p0[3],p1[1]);a=max3f(a,p1[2],p1[3]);
  #pragma unroll
  for(int r=4;r<16;r+=4){a=max3f(a,p0[r],p0[r+1]);b=max3f(b,p0[r+2],p0[r+3]);a=max3f(a,p1[r],p1[r+1]);b=max3f(b,p1[r+2],p1[r+3]);}
  const float m=max2f(a,b);
  auto rr=__builtin_amdgcn_permlane32_swap(__float_as_uint(m),__float_as_uint(m),false,false);
  return max2f(__uint_as_float(rr[0]),__uint_as_float(rr[1]));
}
__device__ __forceinline__ void pv(f32x16*o,int vb,bf16x8 pa0,bf16x8 pa1,bf16x8 pa2,bf16x8 pa3){
  #pragma unroll
  for(int d0=0;d0<2;++d0){s16x4 lo[4],hi[4];
    #pragma unroll
    for(int ks=0;ks<4;++ks){
      asm volatile("ds_read_b64_tr_b16 %0,%1 offset:%c2":"=&v"(lo[ks]):"v"(vb),"i"(d0*4096+ks*1024):"memory");
      asm volatile("ds_read_b64_tr_b16 %0,%1 offset:%c2":"=&v"(hi[ks]):"v"(vb),"i"(d0*4096+ks*1024+512):"memory");}
    asm volatile("s_waitcnt lgkmcnt(0)":::"memory");SBAR();
    #define PK(k) (bf16x8){lo[k][0],lo[k][1],lo[k][2],lo[k][3],hi[k][0],hi[k][1],hi[k][2],hi[k][3]}
    o[d0]=__builtin_amdgcn_mfma_f32_32x32x16_bf16(pa0,PK(0),o[d0],0,0,0);
    o[d0]=__builtin_amdgcn_mfma_f32_32x32x16_bf16(pa1,PK(1),o[d0],0,0,0);
    o[d0]=__builtin_amdgcn_mfma_f32_32x32x16_bf16(pa2,PK(2),o[d0],0,0,0);
    o[d0]=__builtin_amdgcn_mfma_f32_32x32x16_bf16(pa3,PK(3),o[d0],0,0,0);
    #undef PK
  }
}

#ifndef ATTN_STORE16
#define ATTN_STORE16(p,v) (*(u32x4*)(p)=(v))
#endif
template<int THRL> __device__ __forceinline__ void attn_unit(int b,int h,int hv,int qb,const unsigned char*wsb,char*shm,int mode,float lam){ const bf16*Q=(const bf16*)(wsb+ATT_OFF_Q); const bf16*__restrict__ K=(const bf16*)(wsb+ATT_OFF_K); const bf16*__restrict__ V=(const bf16*)(wsb+ATT_OFF_V);
  int tid=threadIdx.x; asm volatile("":"+v"(tid)); const int lane=tid&63,r32=lane&31,hi=lane>>5; const int wid=__builtin_amdgcn_readfirstlane(tid>>6);
  const long rowbase=(long)b*SEQ; const int q0=qb*QB;
  const bf16*Qw=Q+(rowbase+q0+wid*QBLK)*DM+h*D;
  const bf16*Kh=K+rowbase*DM+h*D,*Vh=V+rowbase*DM+hv*D;
  const unsigned lds0=(unsigned)(uintptr_t)shm;
  float*wsf=(float*)(shm+LDS_WS)+wid*64;
  const bf16*ksrc=Kh+(long)lane*DM+wid*8;
  const bf16*vsrc=Vh+(long)(16*(wid&3)+(lane>>2))*DM+(wid>>2)*32+(lane&3)*8;
  const unsigned kdst=lds0+LDS_K+wid*1024, vdst=lds0+LDS_V+wid*1024;
  #define DMA_K(t,slot) glds16(ksrc+(long)(t)*KVBLK*DM,(unsigned)__builtin_amdgcn_readfirstlane(kdst+(slot)))
  #define DMA_V(t,slot) glds16(vsrc+(long)(t)*KVBLK*DM,(unsigned)__builtin_amdgcn_readfirstlane(vdst+(slot)))
  const int vb0=(int)(lds0+LDS_V)+((lane>>4)&1)*32+(lane&3)*8+(4*hi+((lane&15)>>2))*64;
  const char*Kbase=shm+LDS_K; bf16x8 kf[8];
  const lds_cptr shm3=(lds_cptr)shm; const lds_cptr kp0=shm3+LDS_K+hi*1024+r32*16; const lds_cptr vp0=shm3+LDS_V+((lane>>4)&1)*32+(lane&3)*8+(4*hi+((lane&15)>>2))*64;
  const int NT=(q0+QB)/KVBLK;
  DMA_K(0,0);DMA_V(0,0);DMA_K(1,SLOTB);
  bf16x8 qr[4];
  #pragma unroll
  for(int d0=0;d0<4;++d0)qr[d0]=*reinterpret_cast<const bf16x8*>(&Qw[(long)r32*DM+d0*16+hi*8]);
  float mhat=0.f,l_reg=0.f;f32x16 o[2];o[0]=f32x16{};o[1]=f32x16{};f32x16 negm=f32x16{};asm volatile("":"+v"(negm));
  const int qrel=wid*QBLK+r32;
  #define CMASK(P0,P1,t) do{int jb_=(t)-(NT-4); if(jb_>=0)cmask(P0,P1,jb_,qrel,hi);}while(0)
  bool resc=false;
  #define START(P0,P1) do{ const float rm=rowmax(P0,P1); resc=false; \
    { const float dl=rm; mhat=fadd_s(mhat,dl); \
      _Pragma("unroll") for(int r=0;r<16;++r){P0[r]=fsub_s(P0[r],dl);P1[r]=fsub_s(P1[r],dl);} \
      _Pragma("unroll") for(int r=0;r<16;++r)negm[r]=-mhat; asm volatile("":"+v"(negm)); } \
    _Pragma("unroll") for(int r=0;r<16;++r)P0[r]=__builtin_amdgcn_exp2f(P0[r]); }while(0)
  #define RESC() do{ if(resc){ asm volatile("s_waitcnt lgkmcnt(0)":::"memory"); \
      _Pragma("unroll") for(int d_=0;d_<2;++d_) _Pragma("unroll") for(int r=0;r<16;++r)o[d_][r]*=wsf[crow(r,hi)]; } }while(0)
  f32x16 pA0,pA1,pB0,pB1;
  int sl_prev=0,sl_cur=0,sl_next=SLOTB;
  #define ROT() do{sl_prev=sl_cur;sl_cur=sl_next;sl_next=(sl_next==(NSLOT-1)*SLOTB)?0:sl_next+SLOTB;}while(0)
  DMA_K(2,2*SLOTB);
  WAIT_BAR(3);
  qkt(pA0,pA1,Kbase,qr,negm,r32,hi);asm volatile("s_nop 15\n\ts_nop 7":"+v"(pA0),"+v"(pA1));CMASK(pA0,pA1,0);
  START(pA0,pA1);
  _Pragma("unroll") for(int r=0;r<16;++r)pA1[r]=__builtin_amdgcn_exp2f(pA1[r]);
  WAIT_BAR(0);
  DMA_K(3,0);DMA_V(1,SLOTB);
  ROT();
  kload8(kf,kp0+sl_cur);
  WAIT_BAR(2);
  s16x4 vlo[8],vhi[8]; u32x4 pw0,pw1,pw2,pw3;
  #define PKW(P,B) cvtpk_s(P[B],P[B+1])
  #define PAF(k) __builtin_bit_cast(bf16x8,pw##k)
  #define VFR(i) (bf16x8){vlo[i][0],vlo[i][1],vlo[i][2],vlo[i][3],vhi[i][0],vhi[i][1],vhi[i][2],vhi[i][3]}
  #define PIN(x) asm volatile("":"+v"(x))
  #define MX3(a,b,c) __builtin_fmaxf(__builtin_fmaxf((a),(b)),(c))
  #define GAPA(MF,A0,A1,A2,A3,W0,W1,PW) do{ MF; sacc+=A0; sacc+=A1; sacc+=A2; sacc+=A3; PIN(sacc); W0; W1; PIN(PW); SBAR(); }while(0)
  #define EX(v) __builtin_amdgcn_exp2f(v)
  #define GAPB(MF,X,B) do{ MF; X[B]=EX(X[B]); X[B+1]=EX(X[B+1]); X[B+2]=EX(X[B+2]); X[B+3]=EX(X[B+3]); PIN(X); SBAR(); }while(0)
  #define VRD(i) do{ vlo[i]=vtr(vp_+(((i)>>2)*4096+((i)&3)*1024)); vhi[i]=vtr(vp_+(((i)>>2)*4096+((i)&3)*1024+512)); }while(0)
  #define KRD(G,j) do{ if(G){ kload2(kf,kp0+sl_next,j); SBAR(); } }while(0)
  #define STEP(C0,C1,P0,P1,t,GK,GV,GL) do{ SBAR(); \
    const lds_cptr vp_=vp0+sl_prev; \
    VRD(0); SBAR(); float sacc=(P0[0]+P0[1]); \
    GAPA(C0=__builtin_amdgcn_mfma_f32_32x32x16_bf16(kf[0],qr[0],negm,0,0,0), P0[2],P0[3],P0[4],P0[5],     pw0[0]=PKW(P0,0), pw0[1]=PKW(P0,2), pw0); \
    VRD(4); SBAR(); GAPA(C1=__builtin_amdgcn_mfma_f32_32x32x16_bf16(kf[1],qr[0],negm,0,0,0), P0[6],P0[7],P0[8],P0[9],     pw0[2]=PKW(P0,4), pw0[3]=PKW(P0,6), pw0); \
    VRD(1); SBAR(); GAPA(C0=__builtin_amdgcn_mfma_f32_32x32x16_bf16(kf[2],qr[1],C0,0,0,0),   P0[10],P0[11],P0[12],P0[13], pw1[0]=PKW(P0,8), pw1[1]=PKW(P0,10), pw1); \
    VRD(5); SBAR(); GAPA(C1=__builtin_amdgcn_mfma_f32_32x32x16_bf16(kf[3],qr[1],C1,0,0,0),   P0[14],P0[15],P1[0],P1[1],   pw1[2]=PKW(P0,12),pw1[3]=PKW(P0,14), pw1); \
    VRD(2); SBAR(); GAPA(C0=__builtin_amdgcn_mfma_f32_32x32x16_bf16(kf[4],qr[2],C0,0,0,0),   P1[2],P1[3],P1[4],P1[5],     pw2[0]=PKW(P1,0), pw2[1]=PKW(P1,2), pw2); \
    VRD(6); SBAR(); GAPA(C1=__builtin_amdgcn_mfma_f32_32x32x16_bf16(kf[5],qr[2],C1,0,0,0),   P1[6],P1[7],P1[8],P1[9],     pw2[2]=PKW(P1,4), pw2[3]=PKW(P1,6), pw2); \
    VRD(3); SBAR(); GAPA(C0=__builtin_amdgcn_mfma_f32_32x32x16_bf16(kf[6],qr[3],C0,0,0,0),   P1[10],P1[11],P1[12],P1[13], pw3[0]=PKW(P1,8), pw3[1]=PKW(P1,10), pw3); \
    VRD(7); SBAR(); GAPA(C1=__builtin_amdgcn_mfma_f32_32x32x16_bf16(kf[7],qr[3],C1,0,0,0),   P1[14],P1[15],0.f,0.f,       pw3[2]=PKW(P1,12),pw3[3]=PKW(P1,14), pw3); \
    l_reg+=sacc; \
    if(GK){DMA_K((t)+3,sl_cur);} if(GV){DMA_V((t)+1,sl_next);} \
    CMASK(C0,C1,t); \
    { float a=MX3(C0[0],C0[1],C1[0]),b=MX3(C0[2],C0[3],C1[1]); a=MX3(a,C1[2],C1[3]); \
      _Pragma("unroll") for(int r=4;r<16;r+=4){a=MX3(a,C0[r],C0[r+1]);b=MX3(b,C0[r+2],C0[r+3]);a=MX3(a,C1[r],C1[r+1]);b=MX3(b,C1[r+2],C1[r+3]);} \
      float rm=__builtin_fmaxf(a,b); { auto rr=__builtin_amdgcn_permlane32_swap(__float_as_uint(rm),__float_as_uint(rm),false,false); rm=__builtin_fmaxf(__uint_as_float(rr[0]),__uint_as_float(rr[1])); } \
      resc=false; \
      if(__builtin_expect(__any(rm>(float)THRL),0)){ const float dl=__builtin_fmaxf(rm,0.f); mhat+=dl; \
        _Pragma("unroll") for(int r=0;r<16;++r){C0[r]-=dl;C1[r]-=dl;} \
        _Pragma("unroll") for(int r=0;r<16;++r)negm[r]=-mhat; asm volatile("":"+v"(negm)); \
        const float f=__builtin_amdgcn_exp2f(-dl); l_reg*=f; if(hi==0)wsf[r32]=f; resc=true; } } \
    SBAR(); \
    GAPB(o[0]=__builtin_amdgcn_mfma_f32_32x32x16_bf16(PAF(0),VFR(0),o[0],0,0,0), C0,0); \
    GAPB(o[1]=__builtin_amdgcn_mfma_f32_32x32x16_bf16(PAF(0),VFR(4),o[1],0,0,0), C0,4); \
    KRD(GL,0); GAPB(o[0]=__builtin_amdgcn_mfma_f32_32x32x16_bf16(PAF(1),VFR(1),o[0],0,0,0), C0,8); \
    KRD(GL,1); GAPB(o[1]=__builtin_amdgcn_mfma_f32_32x32x16_bf16(PAF(1),VFR(5),o[1],0,0,0), C0,12); \
    KRD(GL,2); GAPB(o[0]=__builtin_amdgcn_mfma_f32_32x32x16_bf16(PAF(2),VFR(2),o[0],0,0,0), C1,0); \
    KRD(GL,3); GAPB(o[1]=__builtin_amdgcn_mfma_f32_32x32x16_bf16(PAF(2),VFR(6),o[1],0,0,0), C1,4); \
    GAPB(o[0]=__builtin_amdgcn_mfma_f32_32x32x16_bf16(PAF(3),VFR(3),o[0],0,0,0), C1,8); \
    GAPB(o[1]=__builtin_amdgcn_mfma_f32_32x32x16_bf16(PAF(3),VFR(7),o[1],0,0,0), C1,12); \
    }while(0)
  int t=1;
  #undef CMASK
  #define CMASK(P0,P1,t) do{}while(0)
  for(;t+5<NT;t+=2){
    STEP(pB0,pB1,pA0,pA1,t,true,true,true);     WAIT_BAR(2); RESC(); ROT();
    STEP(pA0,pA1,pB0,pB1,t+1,true,true,true);   WAIT_BAR(2); RESC(); ROT();
  }
  #undef CMASK
  #define CMASK(P0,P1,t) do{int jb_=(t)-(NT-4); if(jb_>=0)cmask(P0,P1,jb_,qrel,hi);}while(0)
  #define ENDW(tt) do{ if((tt)+3<NT){WAIT_BAR(2);} else if((tt)+2<NT){WAIT_BAR(1);} else {WAIT_BAR(0);} }while(0)
  for(;t+1<NT;t+=2){
    STEP(pB0,pB1,pA0,pA1,t,(t+3<NT),(t+1<NT),(t+1<NT));       ENDW(t);   RESC(); ROT();
    STEP(pA0,pA1,pB0,pB1,t+1,(t+4<NT),(t+2<NT),(t+2<NT));     ENDW(t+1); RESC(); ROT();
  }
  STEP(pB0,pB1,pA0,pA1,NT-1,false,false,false); RESC();
  { float sacc=pB0[0]+pB0[1]; _Pragma("unroll") for(int r=2;r<16;++r)sacc+=pB0[r]; _Pragma("unroll") for(int r=0;r<16;++r)sacc+=pB1[r]; l_reg+=sacc;
    pw0=(u32x4){PKW(pB0,0),PKW(pB0,2),PKW(pB0,4),PKW(pB0,6)};pw1=(u32x4){PKW(pB0,8),PKW(pB0,10),PKW(pB0,12),PKW(pB0,14)};pw2=(u32x4){PKW(pB1,0),PKW(pB1,2),PKW(pB1,4),PKW(pB1,6)};pw3=(u32x4){PKW(pB1,8),PKW(pB1,10),PKW(pB1,12),PKW(pB1,14)};
    SBAR(); pv(o,vb0+sl_cur,PAF(0),PAF(1),PAF(2),PAF(3)); }
  #undef PKW
  #undef PAF
  #undef VFR
  #undef PIN
  #undef MX3
  #undef GAPA
  #undef GAPB
  #undef EX
  #undef VRD
  #undef KRD
  #undef STEP
  #undef ENDW
  {auto rr=__builtin_amdgcn_permlane32_swap(__float_as_uint(l_reg),__float_as_uint(l_reg),false,false);l_reg=__uint_as_float(rr[0])+__uint_as_float(rr[1]);}
  if(hi==0)wsf[32+r32]=l_reg;asm volatile("s_waitcnt lgkmcnt(0)":::"memory");
  float rli[16];
  #pragma unroll
  for(int r=0;r<16;++r)rli[r]=__builtin_amdgcn_rcpf(wsf[32+crow(r,hi)]);
  float*stash=(float*)(shm+LDS_STASH)+wid*2048;
  if(mode==0){
    #pragma unroll
    for(int r=0;r<16;++r){
      #pragma unroll
      for(int d0=0;d0<2;++d0)stash[(d0*16+r)*64+lane]=o[d0][r]*rli[r];}
  }else{
    bf16*O=(bf16*)(const_cast<unsigned char*>(wsb)+ATT_OFF_O); float*ssq=(float*)(const_cast<unsigned char*>(wsb)+ATT_OFF_SSQ);
    bf16*Ow=O+(rowbase+q0+wid*QBLK)*DM+hv*D;
    bf16*stg=(bf16*)(shm+LDS_OST)+wid*2048;
    #pragma unroll
    for(int r=0;r<16;++r){const int orow=crow(r,hi);
      #pragma unroll
      for(int d0=0;d0<2;++d0){const float dv=stash[(d0*16+r)*64+lane]-lam*(o[d0][r]*rli[r]); stg[orow*64+d0*32+r32]=__float2bfloat16(dv);}}
    asm volatile("s_waitcnt lgkmcnt(0)":::"memory");
    #pragma unroll
    for(int i=0;i<4;++i){const int row=i*8+(lane>>3),ch=lane&7; const u32x4 v=*(const u32x4*)(stg+row*64+ch*8);
      float s=0.f;
      #pragma unroll
      for(int w=0;w<4;++w){const float lo_=__uint_as_float(v[w]<<16),hi_=__uint_as_float(v[w]&0xffff0000u); s+=lo_*lo_+hi_*hi_;}
      s+=__shfl_xor(s,1);s+=__shfl_xor(s,2);s+=__shfl_xor(s,4);
      if(ch==0)ssq[(rowbase+q0+wid*QBLK+row)*16+hv]=s;
      ATTN_STORE16(Ow+(long)row*DM+ch*8,v);}
  }
  asm volatile("s_waitcnt lgkmcnt(0)\n\ts_barrier":::"memory");
  #undef DMA_K
  #undef DMA_V
  #undef CMASK
  #undef START
  #undef RESC
  #undef ROT
}
constexpr int ATTN_LDS_BYTES=LDS_BYTES;
#undef SBAR
#undef WAIT_BAR
}

#include <hip/hip_cooperative_groups.h>
namespace cg = cooperative_groups;
#define LAS __attribute__((address_space(3)))
typedef unsigned short bf16;
typedef unsigned v4u __attribute__((ext_vector_type(4)));
typedef float f32x4 __attribute__((ext_vector_type(4)));
typedef short bf16x8 __attribute__((ext_vector_type(8)));
typedef float f32x16 __attribute__((ext_vector_type(16)));
typedef short s16x4 __attribute__((ext_vector_type(4)));

constexpr int NB = 4, SEQ = 8192, M = NB * SEQ, DM = 1024, DEPTH = 4, INW = 6656, DFF = 2816, NMOD = 6 * DM;
constexpr float C2 = 0.125f * 1.4426950408889634f;
constexpr float LOG2E = 1.4426950408889634f;
constexpr size_t MiB = 1u << 20;
constexpr size_t WS_BAR = 0;
constexpr size_t WS_MOD = 512 * 1024;
constexpr size_t WS_ROPE = 1 * MiB;
constexpr size_t WS_SSQ = 9 * MiB;
constexpr size_t WS_WIN = 11 * MiB;
constexpr size_t WS_WA = 24 * MiB, WS_WB = 26 * MiB, WS_WO = 28 * MiB;
constexpr size_t WS_H = 30 * MiB;
constexpr size_t WS_PROJ = 94 * MiB;
constexpr size_t WS_QA = WS_PROJ, WS_KA = WS_QA + 64 * MiB, WS_VA = WS_KA + 64 * MiB, WS_QS = WS_VA + 64 * MiB, WS_KS = WS_QS + 64 * MiB, WS_VS = WS_KS + 16 * MiB, WS_GATES = WS_VS + 16 * MiB;
constexpr size_t WS_GU = WS_PROJ;
constexpr size_t WS_MIXED = WS_KA;
constexpr size_t WS_WGU = WS_PROJ + 352 * MiB;
constexpr size_t WS_WD = WS_WGU + 11 * MiB;
constexpr size_t WS_END = WS_GATES + 128 * MiB;
static_assert(WS_END == 510 * MiB && WS_WD + (size_t)DM * DFF * 2 <= WS_END && WS_GU + (size_t)M * 2 * DFF * 2 <= WS_WGU, "ws map");
constexpr int LDS_BYTES = 155648;

struct Params { const float* in[20]; float* out; unsigned char* ws; };

__device__ __forceinline__ int opaque_tid() { int t = threadIdx.x; asm volatile("" : "+v"(t)); return t; }
template <class T> __device__ __forceinline__ T* opaque_ptr(T* q) {
    unsigned lo = (unsigned)(unsigned long long)q, hi = (unsigned)((unsigned long long)q >> 32);
    asm volatile("" : "+v"(lo), "+v"(hi));
    lo = __builtin_amdgcn_readfirstlane(lo); hi = __builtin_amdgcn_readfirstlane(hi);
    return (T*)(((unsigned long long)hi << 32) | lo); }
__device__ __forceinline__ const float* inptr(const Params& p, int k) { asm volatile("" : "+s"(k)); return p.in[k]; }
static_assert(WS_QA == ATT_OFF_Q && WS_KA == ATT_OFF_K && WS_VA == ATT_OFF_V && WS_H == ATT_OFF_O && WS_SSQ == ATT_OFF_SSQ, "attention workspace offsets");

__device__ __forceinline__ unsigned f2bf(float f) { unsigned u = __builtin_bit_cast(unsigned, f); return (u + 0x7fffu + ((u >> 16) & 1u)) >> 16; }
__device__ __forceinline__ unsigned pk2(float lo, float hi) { typedef float f2 __attribute__((ext_vector_type(2))); typedef __bf16 b2 __attribute__((ext_vector_type(2))); f2 v = {lo, hi}; b2 b = __builtin_convertvector(v, b2); return __builtin_bit_cast(unsigned, b); }
__device__ __forceinline__ float bflo(unsigned w) { return __uint_as_float(w << 16); }
__device__ __forceinline__ float bfhi(unsigned w) { return __uint_as_float(w & 0xffff0000u); }
__device__ __forceinline__ float wave_sum(float v) {
#pragma unroll
    for (int o = 1; o < 64; o <<= 1) v += __shfl_xor(v, o);
    return v;
}
__device__ __forceinline__ float fast_sigmoid(float x) { return __builtin_amdgcn_rcpf(1.0f + __builtin_amdgcn_exp2f(-x * LOG2E)); }
__device__ __forceinline__ float fast_silu(float x) { return x * fast_sigmoid(x); }
__device__ __forceinline__ float lambda_init_of(int l) { return l == 0 ? 0.2f : l == 1 ? 0.35550906759096926f : l == 2 ? 0.47071301834358413f : 0.5560582041564726f; }

struct EpiIn {
    static constexpr bool PERM = true, AFTER_DRAIN = false;
    unsigned char* ws; const float* rope;
    __device__ __forceinline__ void operator()(const pg8::f32x4 (&acc)[2][2][4][2], const pg8::Unit& u, int wr, int wc, int fr, int fq) const {
        const int pn = u.pn; bf16* base; int ld, kind;
        if (pn < 4)        { base = (bf16*)(ws + WS_QA) + pn * 256;        ld = 1024; kind = 0; }
        else if (pn < 8)   { base = (bf16*)(ws + WS_KA) + (pn - 4) * 256;  ld = 1024; kind = 1; }
        else if (pn < 12)  { base = (bf16*)(ws + WS_VA) + (pn - 8) * 256;  ld = 1024; kind = 2; }
        else if (pn < 16)  { base = (bf16*)(ws + WS_QS) + (pn - 12) * 256; ld = 1024; kind = 0; }
        else if (pn == 16) { base = (bf16*)(ws + WS_KS);                   ld = 256;  kind = 1; }
        else if (pn == 17) { base = (bf16*)(ws + WS_VS);                   ld = 256;  kind = 2; }
        else               { base = (bf16*)(ws + WS_GATES) + (pn - 18) * 256; ld = 2048; kind = 3; }
        const int row0 = u.pm * 256 + wr * 64 + fr, colp = 64 * wc + 8 * fq;
#pragma unroll
        for (int ai = 0; ai < 2; ++ai)
#pragma unroll
            for (int m = 0; m < 4; ++m) {
                const int row = row0 + ai * 128 + m * 16;
                pg8::f32x4 a0 = acc[ai][0][m][0], a1 = acc[ai][0][m][1], b0 = acc[ai][1][m][0], b1 = acc[ai][1][m][1];
                if (kind <= 1) {
                    const float* rp = rope + (size_t)row * 64 + 8 * fq;
                    const pg8::f32x4 c0 = *(const pg8::f32x4*)rp, c1 = *(const pg8::f32x4*)(rp + 4), s0 = *(const pg8::f32x4*)(rp + 32), s1 = *(const pg8::f32x4*)(rp + 36);
                    const pg8::f32x4 o1a = a0 * c0 - b0 * s0, o1b = a1 * c1 - b1 * s1, o2a = b0 * c0 + a0 * s0, o2b = b1 * c1 + a1 * s1;
                    const float sc = (kind == 0) ? C2 : 1.0f;
                    a0 = o1a * sc; a1 = o1b * sc; b0 = o2a * sc; b1 = o2b * sc;
                } else if (kind == 3) {
#pragma unroll
                    for (int i = 0; i < 4; ++i) { a0[i] = fast_sigmoid(a0[i]); a1[i] = fast_sigmoid(a1[i]); b0[i] = fast_sigmoid(b0[i]); b1[i] = fast_sigmoid(b1[i]); }
                }
                pg8::u32x4 w1, w2;
                w1.x = pk2(a0[0], a0[1]); w1.y = pk2(a0[2], a0[3]); w1.z = pk2(a1[0], a1[1]); w1.w = pk2(a1[2], a1[3]);
                w2.x = pk2(b0[0], b0[1]); w2.y = pk2(b0[2], b0[3]); w2.z = pk2(b1[0], b1[1]); w2.w = pk2(b1[2], b1[3]);
                bf16* rowp = base + (size_t)row * ld + colp;
                *(pg8::u32x4*)rowp = w1; *(pg8::u32x4*)(rowp + 32) = w2;
            }
    }
};
struct EpiBranch {
    static constexpr bool PERM = true, AFTER_DRAIN = false;
    const bf16* gates; bf16* mixed;
    __device__ __forceinline__ void operator()(const pg8::f32x4 (&acc)[2][2][4][2], const pg8::Unit& u, int wr, int wc, int fr, int fq) const {
        const int row0 = u.pm * 256 + wr * 64 + fr, col0 = u.pn * 256 + wc * 32 + 8 * fq, br = u.br;
#pragma unroll
        for (int ai = 0; ai < 2; ++ai)
#pragma unroll
            for (int m = 0; m < 4; ++m) {
                const int row = row0 + ai * 128 + m * 16;
#pragma unroll
                for (int bj = 0; bj < 2; ++bj) {
                    const int col = col0 + bj * 128;
                    const pg8::u32x4 gv = *(const pg8::u32x4*)(gates + (size_t)row * 2048 + br * 1024 + col);
                    const pg8::f32x4 v0 = acc[ai][bj][m][0], v1 = acc[ai][bj][m][1];
                    float r[8];
                    r[0] = bflo(gv.x) * v0[0]; r[1] = bfhi(gv.x) * v0[1]; r[2] = bflo(gv.y) * v0[2]; r[3] = bfhi(gv.y) * v0[3];
                    r[4] = bflo(gv.z) * v1[0]; r[5] = bfhi(gv.z) * v1[1]; r[6] = bflo(gv.w) * v1[2]; r[7] = bfhi(gv.w) * v1[3];
                    bf16* mp = mixed + (size_t)row * 1024 + col;
                    if (br) { const pg8::u32x4 t = *(const pg8::u32x4*)mp;
                        r[0] += bflo(t.x); r[1] += bfhi(t.x); r[2] += bflo(t.y); r[3] += bfhi(t.y); r[4] += bflo(t.z); r[5] += bfhi(t.z); r[6] += bflo(t.w); r[7] += bfhi(t.w); }
                    pg8::u32x4 w; w.x = pk2(r[0], r[1]); w.y = pk2(r[2], r[3]); w.z = pk2(r[4], r[5]); w.w = pk2(r[6], r[7]);
                    *(pg8::u32x4*)mp = w;
                }
            }
    }
};
struct EpiResid {
    static constexpr bool PERM = false, AFTER_DRAIN = false;
    const float* xin; float* xout; const float* gate;
    float gs;
    __device__ __forceinline__ void operator()(const pg8::f32x4 (&acc)[2][2][4][2], const pg8::Unit& u, int wr, int wc, int fr, int fq) const {
        const int b = (u.pm * 256) / SEQ; const float* gv = gate + (size_t)b * NMOD;
        const int row0 = u.pm * 256 + wr * 64 + fr, col0 = u.pn * 256 + wc * 32 + 4 * fq;
#pragma unroll
        for (int bj = 0; bj < 2; ++bj)
#pragma unroll
            for (int n = 0; n < 2; ++n) {
                const int col = col0 + bj * 128 + n * 16;
                const pg8::f32x4 g = *(const pg8::f32x4*)(gv + col) * gs;
#pragma unroll
                for (int ai = 0; ai < 2; ++ai)
#pragma unroll
                    for (int m = 0; m < 4; ++m) {
                        const size_t off = (size_t)(row0 + ai * 128 + m * 16) * DM + col;
                        const pg8::f32x4 xi = *(const pg8::f32x4*)(xin + off);
                        *(pg8::f32x4*)(xout + off) = xi + g * acc[ai][bj][m][n];
                    }
            }
    }
};
struct BranchOrder {
    pg8::StaticOrder S;
    __device__ __forceinline__ bool next(int i, pg8::Unit& u) const { if (!S.next(i >> 1, u)) return false; u.br = i & 1; return true; }
    __device__ __forceinline__ void a_ready(const pg8::Unit&) const {}
    __device__ __forceinline__ void done(const pg8::Unit&) const {}
};

__device__ __forceinline__ void transpose_item(const float* W, int K, int N, bf16* WT, int row_off, bool perm, LAS float* scr, int item, int lane) {
    const int nblk = N / 32, kb = item / nblk, nb = item % nblk, k0 = 64 * kb, n0 = 32 * nb;
#pragma unroll 8
    for (int i = 0; i < 32; ++i) { const int kk = 2 * i + (lane >> 5); scr[kk * 33 + (lane & 31)] = W[(size_t)(k0 + kk) * N + n0 + (lane & 31)]; }
    asm volatile("s_waitcnt lgkmcnt(0)" ::: "memory");
    const int d0 = perm ? ((n0 & ~255) + 128 * ((n0 >> 5) & 1) + 32 * ((n0 >> 6) & 3)) : n0;
    const int c = lane & 7;
#pragma unroll
    for (int j = 0; j < 4; ++j) { const int n = (lane >> 3) + 8 * j; const LAS float* s = scr + (8 * c) * 33 + n;
        v4u o; o.x = pk2(s[0 * 33], s[1 * 33]); o.y = pk2(s[2 * 33], s[3 * 33]); o.z = pk2(s[4 * 33], s[5 * 33]); o.w = pk2(s[6 * 33], s[7 * 33]);
        *(v4u*)(WT + (size_t)(row_off + d0 + n) * K + k0 + 8 * c) = o; }
    asm volatile("s_waitcnt lgkmcnt(0)" ::: "memory");
}
__device__ __forceinline__ void rms_row_to_bf16(const float* xrow, bf16* orow, const float* gn, const float* sc, const float* sh, int lane) {
    const f32x4* xr = (const f32x4*)xrow + lane;
    f32x4 v[4]; float s = 0.f;
#pragma unroll
    for (int j = 0; j < 4; ++j) { v[j] = xr[64 * j]; s += (v[j].x * v[j].x + v[j].y * v[j].y) + (v[j].z * v[j].z + v[j].w * v[j].w); }
    const float rstd = 1.0f / sqrtf(wave_sum(s) * (1.f / DM) + 1e-6f);
    unsigned long long* o8 = (unsigned long long*)orow + lane;
#pragma unroll
    for (int j = 0; j < 4; ++j) {
        const f32x4 g = ((const f32x4*)gn)[lane + 64 * j], c = ((const f32x4*)sc)[lane + 64 * j], h = ((const f32x4*)sh)[lane + 64 * j];
        const f32x4 y = (v[j] * rstd) * g * (c + 1.0f) + h;
        o8[64 * j] = (unsigned long long)pk2(y.x, y.y) | ((unsigned long long)pk2(y.z, y.w) << 32);
    }
}
__device__ __forceinline__ void sincos_acc(float ang, float& sn, float& cs) {
    const double a = (double)ang;
    const double kf = __builtin_rint(a * 0.6366197723675814);
    double r = __builtin_fma(-kf, 1.5707963267948966, a); r = __builtin_fma(-kf, 6.123233995736766e-17, r);
    const double r2 = r * r;
    double sp = -1.0 / 6227020800.0 * 0.0 + 1.0 / 6227020800.0;
    sp = sp * r2 - 1.0 / 39916800.0; sp = sp * r2 + 1.0 / 362880.0; sp = sp * r2 - 1.0 / 5040.0; sp = sp * r2 + 1.0 / 120.0; sp = sp * r2 - 1.0 / 6.0; sp = sp * r2 + 1.0;
    const double s = sp * r;
    double cp = 1.0 / 479001600.0;
    cp = cp * r2 - 1.0 / 3628800.0; cp = cp * r2 + 1.0 / 40320.0; cp = cp * r2 - 1.0 / 720.0; cp = cp * r2 + 1.0 / 24.0; cp = cp * r2 - 0.5; cp = cp * r2 + 1.0;
    const int q = ((int)kf) & 3;
    const double ss = (q == 0) ? s : (q == 1) ? cp : (q == 2) ? -s : -cp;
    const double cc = (q == 0) ? cp : (q == 1) ? -s : (q == 2) ? -cp : s;
    sn = (float)ss; cs = (float)cc;
}

constexpr int SWA_KP = 144, SWA_VP = 528;
__device__ __forceinline__ void swa_unit(int b, int kvh, int qblk, bf16* Qs, const bf16* Ks, const bf16* Vs, const float* sinks, LAS unsigned char* lds, bf16* dummy = nullptr) {
    const int tid = opaque_tid(), lane = tid & 63, r32 = lane & 31, hi = lane >> 5; const int wid = __builtin_amdgcn_readfirstlane(tid >> 6);
    const long rowbase = (long)b * SEQ; const int q0 = qblk * 128, kv0 = q0 - 128;
    LAS unsigned char* Kl = lds; LAS unsigned char* Vt = lds + 256 * SWA_KP;
#pragma unroll
    for (int i = 0; i < 4; ++i) {
        const int ch = tid + 512 * i, row = ch >> 3, c8 = ch & 7, kabs = kv0 + row;
        v4u kv = {0u, 0u, 0u, 0u}, vv = {0u, 0u, 0u, 0u};
        if (kabs >= 0) { kv = *(const v4u*)(Ks + (size_t)(rowbase + kabs) * 256 + kvh * 64 + c8 * 8); vv = *(const v4u*)(Vs + (size_t)(rowbase + kabs) * 256 + kvh * 64 + c8 * 8); }
        *(LAS v4u*)(Kl + row * SWA_KP + c8 * 16) = kv;
#pragma unroll
        for (int j = 0; j < 4; ++j) { const unsigned w = vv[j];
            *(LAS unsigned short*)(Vt + (c8 * 8 + 2 * j) * SWA_VP + row * 2) = (unsigned short)(w & 0xffffu);
            *(LAS unsigned short*)(Vt + (c8 * 8 + 2 * j + 1) * SWA_VP + row * 2) = (unsigned short)(w >> 16); }
    }
    __syncthreads();
#pragma unroll 1
    for (int tt = 0; tt < 2; ++tt) {
        const int task = wid * 2 + tt, g = task >> 2, t = task & 3, qh = kvh * 4 + g;
        bf16* qp = Qs + (size_t)(rowbase + q0 + 32 * t + r32) * 1024 + qh * 64 + hi * 8;
        bf16x8 qr[4];
#pragma unroll
        for (int d0 = 0; d0 < 4; ++d0) qr[d0] = *(const bf16x8*)(qp + d0 * 16);
        const float sink2 = sinks[qh] * LOG2E;
        f32x16 p[5];
#pragma unroll
        for (int jt = 0; jt < 5; ++jt) {
            const LAS unsigned char* kb = Kl + ((t + jt) * 32 + r32) * SWA_KP + hi * 16;
            f32x16 a = {};
#pragma unroll
            for (int d0 = 0; d0 < 4; ++d0) { const bf16x8 kf = *(const LAS bf16x8*)(kb + d0 * 32); a = __builtin_amdgcn_mfma_f32_32x32x16_bf16(kf, qr[d0], a, 0, 0, 0); }
            p[jt] = a;
        }
        float mx = sink2;
#pragma unroll
        for (int jt = 0; jt < 5; ++jt)
#pragma unroll
            for (int i = 0; i < 16; ++i) {
                const int cr = (i & 3) + 8 * (i >> 2) + 4 * hi, dlt = 128 + r32 - 32 * jt - cr, kabs = kv0 + (t + jt) * 32 + cr;
                const bool vis = (dlt >= 0) && (dlt < 128) && (kabs >= 0);
                p[jt][i] = vis ? p[jt][i] : -INFINITY; mx = fmaxf(mx, p[jt][i]);
            }
        mx = fmaxf(mx, __shfl_xor(mx, 32));
        float sum = 0.f;
#pragma unroll
        for (int jt = 0; jt < 5; ++jt)
#pragma unroll
            for (int i = 0; i < 16; ++i) { const float e = __builtin_amdgcn_exp2f(p[jt][i] - mx); p[jt][i] = e; sum += e; }
        sum += __shfl_xor(sum, 32);
        const float linv = 1.0f / (sum + __builtin_amdgcn_exp2f(sink2 - mx));
        f32x16 o[2]; o[0] = f32x16{}; o[1] = f32x16{};
#pragma unroll
        for (int jt = 0; jt < 5; ++jt)
#pragma unroll
            for (int s = 0; s < 2; ++s) {
                v4u pw; pw.x = pk2(p[jt][8 * s], p[jt][8 * s + 1]); pw.y = pk2(p[jt][8 * s + 2], p[jt][8 * s + 3]); pw.z = pk2(p[jt][8 * s + 4], p[jt][8 * s + 5]); pw.w = pk2(p[jt][8 * s + 6], p[jt][8 * s + 7]);
                const bf16x8 pa = __builtin_bit_cast(bf16x8, pw);
#pragma unroll
                for (int d0 = 0; d0 < 2; ++d0) {
                    const LAS unsigned char* vp = Vt + (d0 * 32 + r32) * SWA_VP + ((t + jt) * 32 + 16 * s + 4 * hi) * 2;
                    const s16x4 lo = *(const LAS s16x4*)vp, h4 = *(const LAS s16x4*)(vp + 16);
                    const bf16x8 vb = __builtin_shufflevector(lo, h4, 0, 1, 2, 3, 4, 5, 6, 7);
                    o[d0] = __builtin_amdgcn_mfma_f32_32x32x16_bf16(pa, vb, o[d0], 0, 0, 0);
                }
            }
        bf16* op = dummy ? dummy + (size_t)((q0 + 32 * t) & 4095) * 1024 + qh * 64 + r32 : Qs + (size_t)(rowbase + q0 + 32 * t) * 1024 + qh * 64 + r32;
#pragma unroll
        for (int i = 0; i < 16; ++i) {
            const int cr = (i & 3) + 8 * (i >> 2) + 4 * hi; const float li = __shfl(linv, cr);
            op[(size_t)cr * 1024] = (bf16)f2bf(o[0][i] * li); op[(size_t)cr * 1024 + 32] = (bf16)f2bf(o[1][i] * li);
        }
    }
    __syncthreads();
}

#define XB_TMO      128
#define XB_XCNT(j)  (256  + 64 * (j))
#define XB_XSUB(j)  (1280 + 64 * (j))
#define XB_XGEN(j)  (2304 + 64 * (j))
#define XB_TOP      3328
#define XB_TOPGEN   3392
#define XCD_BAR_WORDS 3456
#define XB_SPIN_CAP (1u << 18)

__device__ __forceinline__ unsigned xb_ld(unsigned* p)              { return __hip_atomic_load(p, __ATOMIC_RELAXED, __HIP_MEMORY_SCOPE_AGENT); }
__device__ __forceinline__ unsigned xb_add(unsigned* p, unsigned v) { return __hip_atomic_fetch_add(p, v, __ATOMIC_RELAXED, __HIP_MEMORY_SCOPE_AGENT); }
__device__ __forceinline__ unsigned xb_xcc_id() { return (unsigned)__builtin_amdgcn_s_getreg((3 << 11) | 20) & 0xFu; }
#define XB_SPIN(cond, bar) do { unsigned _sp = 0; while (cond) { __builtin_amdgcn_s_sleep(1); \
    if ((++_sp & 255u) == 0u) { if (xb_ld(&(bar)[XB_TMO])) break; if (_sp > XB_SPIN_CAP) { atomicAdd(&(bar)[XB_TMO], 1u); break; } } } } while (0)

struct XcdBarrier {
    unsigned* bar; unsigned x;
    volatile LAS unsigned* st;
};

__device__ __forceinline__ XcdBarrier xcd_barrier_post(unsigned* bar, volatile LAS unsigned* st) {
    XcdBarrier b; b.bar = bar; b.x = xb_xcc_id(); b.st = st;
    if (threadIdx.x == 0) (void)xb_add(&bar[XB_XCNT(b.x)], 1u);
    return b;
}
__device__ __forceinline__ void xcd_barrier_complete(unsigned* bar, unsigned x, unsigned& nloc, unsigned& nx) {
    const unsigned G = gridDim.x * gridDim.y * gridDim.z;
    unsigned sum, cnt, mine, sp = 0u;
    for (;;) {
        sum = 0u; cnt = 0u; mine = 0u;
#pragma unroll
        for (unsigned j = 0; j < 16; ++j) { const unsigned c = xb_ld(&bar[XB_XCNT(j)]); sum += c; cnt += (c > 0u) ? 1u : 0u; mine = (j == x) ? c : mine; }
        if (sum == G) break;
        __builtin_amdgcn_s_sleep(1);
        if ((++sp & 255u) == 0u) { if (xb_ld(&bar[XB_TMO])) break; if (sp > XB_SPIN_CAP) { atomicAdd(&bar[XB_TMO], 1u); break; } }
    }
    nloc = mine > 0u ? mine : 1u; nx = cnt > 0u ? cnt : 1u;
}

__device__ __forceinline__ void xcd_barrier(const XcdBarrier& b) {
    asm volatile("s_waitcnt vmcnt(0)" ::: "memory");
    __syncthreads();
    if (threadIdx.x == 0) {
        unsigned* bar = b.bar;
        __builtin_amdgcn_s_waitcnt(0);
        unsigned nloc = b.st[0], nx = b.st[1];
        if (nloc == 0u) { xcd_barrier_complete(bar, b.x, nloc, nx); b.st[0] = nloc; b.st[1] = nx; }
        const unsigned old = xb_add(&bar[XB_XSUB(b.x)], 1u);
        const unsigned gen = old / nloc;
        if (old + 1u == (gen + 1u) * nloc) {
            __builtin_amdgcn_fence(__ATOMIC_RELEASE, "agent");
            asm volatile("s_waitcnt vmcnt(0)" ::: "memory");
            const unsigned og = xb_add(&bar[XB_TOP], 1u);
            const unsigned tg = og / nx;
            if (og + 1u == (tg + 1u) * nx) xb_add(&bar[XB_TOPGEN], 1u);
            else XB_SPIN(xb_ld(&bar[XB_TOPGEN]) == tg, bar);
            __builtin_amdgcn_fence(__ATOMIC_ACQUIRE, "agent");
            xb_add(&bar[XB_XGEN(b.x)], 1u);
            asm volatile("s_waitcnt vmcnt(0)" ::: "memory");
        } else {
            XB_SPIN(xb_ld(&bar[XB_XGEN(b.x)]) == gen, bar);
            __builtin_amdgcn_fence(__ATOMIC_ACQUIRE, "agent");
            asm volatile("s_waitcnt vmcnt(0)" ::: "memory");
        }
    }
    __syncthreads();
}

#ifdef PROBE_SYNC2
#define GSYNC() do { xcd_barrier(xbar); xcd_barrier(xbar); } while (0)
#else
#define GSYNC() xcd_barrier(xbar)
#endif
#define PH_TID() const int tid = opaque_tid(), lane = tid & 63, wave = __builtin_amdgcn_readfirstlane(tid >> 6); (void)lane; (void)wave; \
    const int gw = vcu * 8 + wave, NGW = G * 8; (void)gw; (void)NGW; unsigned char* ws = opaque_ptr(p.ws); (void)ws
__global__ void __launch_bounds__(512, 2) fwd_megakernel(Params p) {
    extern __shared__ __attribute__((aligned(16))) unsigned char lds_raw[];
    cg::grid_group grid = cg::this_grid();
    LAS unsigned char* lds = (LAS unsigned char*)lds_raw;
    const int G = gridDim.x, bx = blockIdx.x;
    const int vcu = (G % 8 == 0) ? (bx % 8) * (G / 8) + bx / 8 : bx;
    volatile LAS unsigned* xst = (volatile LAS unsigned*)(lds + LDS_BYTES - 64);
    if (threadIdx.x < 2) xst[threadIdx.x] = 0u;
    __syncthreads();
    const XcdBarrier xbar = xcd_barrier_post((unsigned*)(p.ws + WS_BAR), xst);

#ifndef SKIP_P0
#ifdef PROBE_P02
    for (int rep_ = 0; rep_ < 2; ++rep_)
#endif
    {
        const int tid = threadIdx.x, lane = tid & 63, wave = __builtin_amdgcn_readfirstlane(tid >> 6); unsigned char* ws = p.ws;
        const float* c_in = p.in[1]; const int* pos = (const int*)p.in[2]; const float* w_ada = p.in[3]; const float* b_ada = p.in[4];
        float* mod = (float*)(ws + WS_MOD); float* rope = (float*)(ws + WS_ROPE);
#ifndef SKIP_ROPE
        for (int e0 = bx * 512; e0 < M * 32; e0 += G * 512) {
            const int e = e0 + tid; const int row = e >> 5, i = e & 31;
            const float inv_freq = (float)exp2(-(double)(2 * i) * (13.287712379549449 / 64.0));
            const float ang = (float)pos[row] * inv_freq;
            float sn, cs; sincos_acc(ang, sn, cs);
            rope[(size_t)row * 64 + i] = cs; rope[(size_t)row * 64 + 32 + i] = sn;
        }
#endif
#ifndef SKIP_MOD
        {
            LAS float* cact = (LAS float*)lds;
            LAS float* red = (LAS float*)(lds + 16384);
            for (int e = tid; e < NB * DM; e += 512) cact[e] = fast_silu(c_in[e]);
            __syncthreads();
            for (int unit = bx; unit < DEPTH * 96; unit += G) {
                const int l = unit / 96, col = (unit % 96) * 64 + lane;
                const float* Wp = w_ada + (size_t)l * DM * NMOD + (size_t)(wave * 128) * NMOD + col;
                float a0 = 0.f, a1 = 0.f, a2 = 0.f, a3 = 0.f;
#pragma unroll 8
                for (int kk = 0; kk < 128; ++kk) { const float w = Wp[(size_t)kk * NMOD]; const int k = wave * 128 + kk;
                    a0 += cact[k] * w; a1 += cact[1024 + k] * w; a2 += cact[2048 + k] * w; a3 += cact[3072 + k] * w; }
                red[(wave * 4 + 0) * 64 + lane] = a0; red[(wave * 4 + 1) * 64 + lane] = a1; red[(wave * 4 + 2) * 64 + lane] = a2; red[(wave * 4 + 3) * 64 + lane] = a3;
                __syncthreads();
                if (wave < 4) { float s = b_ada[(size_t)l * NMOD + col];
#pragma unroll
                    for (int w = 0; w < 8; ++w) s += red[(w * 4 + wave) * 64 + lane];
                    mod[(size_t)(l * NB + wave) * NMOD + col] = s; }
                __syncthreads();
            }
        }
#endif
    }
#endif
    grid.sync();

#pragma unroll 1
    for (int l = 0; l < DEPTH; ++l) {
#ifndef SKIP_P1
#ifdef PROBE_THIN2
        for (int rep_ = 0; rep_ < 2; ++rep_)
#endif
        {
            PH_TID();
            LAS float* scr = (LAS float*)(lds + wave * 16384);
            const float* xcur = (l == 0) ? inptr(p, 0) : (const float*)opaque_ptr(p.out);
            const float* modl = (const float*)(ws + WS_MOD) + (size_t)l * NB * NMOD;
            const float* w_in = inptr(p, 6); const float* w_ba = inptr(p, 10); const float* w_bb = inptr(p, 11); const float* w_out = inptr(p, 12); const float* attn_norm = inptr(p, 5);
            constexpr int I_IN = 16 * (INW / 32), I_SQ = 16 * 32;
            for (int it = gw; it < I_IN + 3 * I_SQ; it += NGW) {
                int r = it;
                if (r < I_IN) { transpose_item(w_in + (size_t)l * DM * INW, DM, INW, (bf16*)(ws + WS_WIN), 0, true, scr, r, lane); continue; } r -= I_IN;
                if (r < I_SQ) { transpose_item(w_ba + (size_t)l * DM * DM, DM, DM, (bf16*)(ws + WS_WA), 0, false, scr, r, lane); continue; } r -= I_SQ;
                if (r < I_SQ) { transpose_item(w_bb + (size_t)l * DM * DM, DM, DM, (bf16*)(ws + WS_WB), 0, false, scr, r, lane); continue; } r -= I_SQ;
                transpose_item(w_out + (size_t)l * DM * DM, DM, DM, (bf16*)(ws + WS_WO), 0, false, scr, r, lane);
            }
            bf16* H = (bf16*)(ws + WS_H);
            for (int m = gw; m < M; m += NGW) { const float* mb = modl + (size_t)(m / SEQ) * NMOD;
                rms_row_to_bf16(xcur + (size_t)m * DM, H + (size_t)m * DM, attn_norm + l * DM, mb + 1024, mb, lane); }
        }
#endif
        GSYNC();
#ifndef SKIP_P2
#ifdef PROBE_GEMM2
        for (int rep_ = 0; rep_ < 2; ++rep_)
#endif
        {
            unsigned char* ws = opaque_ptr(p.ws);
            pg8::Gemm g{(const bf16*)(ws + WS_H), (const bf16*)(ws + WS_WIN), DM, DM, DM, 0, 0}; pg8::StaticOrder S; S.init(M, INW, G, bx);
            EpiIn E{ws, (const float*)(ws + WS_ROPE)};
            pg8::gemm_phase<EpiIn, pg8::StaticOrder, PG8_ALIGN, PG8_SP2>(lds, g, S, E);
        }
#endif
        GSYNC();
#ifndef SKIP_P3
        {
#ifndef SKIP_ATTN
            float lam;
            { const int ln = opaque_tid() & 63; const float* lq = inptr(p, 7) + l * 256;
              const float s1 = wave_sum(lq[ln] * lq[64 + ln]), s2 = wave_sum(lq[128 + ln] * lq[192 + ln]);
              lam = __uint_as_float(__builtin_amdgcn_readfirstlane(__float_as_uint(expf(s1) - expf(s2) + lambda_init_of(l)))); }
#ifdef PROBE_ATTN2
            for (int rep_ = 0; rep_ < 2; ++rep_)
#endif
            for (int it = vcu; it < 1024; it += G) {
                const int combo = it >> 4, pr = it & 15, b = combo >> 4, h = (combo >> 1) & 7, vh = combo & 1;
#pragma unroll 1
                for (int k = 0; k < 2; ++k) {
                    const int qb = k ? 31 - pr : pr;
#pragma unroll 1
                    for (int c = 0; c < 2; ++c)
                        attn_body::attn_unit<8>(b, 2 * h + c, 2 * h + vh, qb, opaque_ptr(p.ws), (char*)lds_raw, c, lam);
                }
            }
#endif
#ifndef SKIP_SWA
            { const float* sinks = inptr(p, 9) + l * 16;
#ifdef PROBE_SWA2
              for (int u = vcu; u < 1024; u += G) { unsigned char* ws = opaque_ptr(p.ws); swa_unit(u >> 8, (u >> 6) & 3, u & 63, (bf16*)(ws + WS_QS), (const bf16*)(ws + WS_KS), (const bf16*)(ws + WS_VS), sinks, lds, (bf16*)(ws + WS_WIN)); }
#endif
              for (int u = vcu; u < 1024; u += G) { unsigned char* ws = opaque_ptr(p.ws); swa_unit(u >> 8, (u >> 6) & 3, u & 63, (bf16*)(ws + WS_QS), (const bf16*)(ws + WS_KS), (const bf16*)(ws + WS_VS), sinks, lds); } }
#endif
        }
#endif
        GSYNC();
#ifndef SKIP_P4
#ifdef PROBE_THIN2
        for (int rep_ = 0; rep_ < 2; ++rep_)
#endif
        {
            PH_TID();
            const float* ssq = (const float*)(ws + WS_SSQ); const bf16* H = (const bf16*)(ws + WS_H); bf16* QA = (bf16*)(ws + WS_QA);
            const float* subln = inptr(p, 8); const float lam_init = lambda_init_of(l);
            for (int m = gw; m < M; m += NGW) {
                const int head = lane >> 3, e0 = (lane & 7) * 16;
                const float ss = ssq[(size_t)m * 16 + 2 * head] + ssq[(size_t)m * 16 + 2 * head + 1];
                const float rs = (1.0f / sqrtf(ss * (1.f / 128.f) + 1e-5f)) * (1.0f - lam_init);
                const v4u d0 = *(const v4u*)(H + (size_t)m * DM + lane * 16), d1 = *(const v4u*)(H + (size_t)m * DM + lane * 16 + 8);
                const float* gp = subln + l * 128 + e0;
                v4u o0, o1;
                o0.x = pk2(bflo(d0.x) * rs * gp[0], bfhi(d0.x) * rs * gp[1]); o0.y = pk2(bflo(d0.y) * rs * gp[2], bfhi(d0.y) * rs * gp[3]);
                o0.z = pk2(bflo(d0.z) * rs * gp[4], bfhi(d0.z) * rs * gp[5]); o0.w = pk2(bflo(d0.w) * rs * gp[6], bfhi(d0.w) * rs * gp[7]);
                o1.x = pk2(bflo(d1.x) * rs * gp[8], bfhi(d1.x) * rs * gp[9]); o1.y = pk2(bflo(d1.y) * rs * gp[10], bfhi(d1.y) * rs * gp[11]);
                o1.z = pk2(bflo(d1.z) * rs * gp[12], bfhi(d1.z) * rs * gp[13]); o1.w = pk2(bflo(d1.w) * rs * gp[14], bfhi(d1.w) * rs * gp[15]);
                *(v4u*)(QA + (size_t)m * DM + lane * 16) = o0; *(v4u*)(QA + (size_t)m * DM + lane * 16 + 8) = o1;
            }
        }
#endif
        GSYNC();
#ifndef SKIP_P5
#ifdef PROBE_GEMM2
        for (int rep_ = 0; rep_ < 2; ++rep_)
#endif
        {
            unsigned char* ws = opaque_ptr(p.ws);
            pg8::Gemm g{(const bf16*)(ws + WS_QA), (const bf16*)(ws + WS_WA), DM, DM, DM, (size_t)(WS_QS - WS_QA), (size_t)(WS_WB - WS_WA)}; BranchOrder S; S.S.init(M, DM, G, bx);
            EpiBranch E{(const bf16*)(ws + WS_GATES), (bf16*)(ws + WS_MIXED)};
            pg8::gemm_phase<EpiBranch, BranchOrder, PG8_ALIGN, PG8_SP2>(lds, g, S, E);
        }
#endif
        GSYNC();
#ifndef SKIP_P6
#ifdef PROBE_RES2
        for (int repp6_ = 0; repp6_ < 2; ++repp6_)
#else
        const int repp6_ = 1;
#endif
        {
            unsigned char* ws = opaque_ptr(p.ws);
            float* out = (float*)opaque_ptr(p.out);
            const float* xcur = (l == 0) ? inptr(p, 0) : (const float*)out;
            pg8::Gemm g{(const bf16*)(ws + WS_MIXED), (const bf16*)(ws + WS_WO), DM, DM, DM, 0, 0}; pg8::StaticOrder S; S.init(M, DM, G, bx);
            EpiResid E{repp6_ ? xcur : (const float*)out, out, (const float*)(ws + WS_MOD) + (size_t)l * NB * NMOD + 2048, repp6_ ? 1.f : 0.f};
            pg8::gemm_phase<EpiResid, pg8::StaticOrder, PG8_ALIGN, PG8_SP2>(lds, g, S, E);
        }
#endif
        GSYNC();
#ifndef SKIP_P7
#ifdef PROBE_THIN2
        for (int rep_ = 0; rep_ < 2; ++rep_)
#endif
        {
            PH_TID();
            LAS float* scr = (LAS float*)(lds + wave * 16384);
            const float* out = (const float*)opaque_ptr(p.out);
            const float* modl = (const float*)(ws + WS_MOD) + (size_t)l * NB * NMOD;
            const float* w_gate = inptr(p, 14); const float* w_up = inptr(p, 15); const float* w_down = inptr(p, 18); const float* ffn_norm = inptr(p, 13);
            constexpr int I_G = 16 * (DFF / 32), I_D = (DFF / 64) * 32;
            for (int it = gw; it < 2 * I_G + I_D; it += NGW) {
                int r = it;
                if (r < I_G) { transpose_item(w_gate + (size_t)l * DM * DFF, DM, DFF, (bf16*)(ws + WS_WGU), 0, false, scr, r, lane); continue; } r -= I_G;
                if (r < I_G) { transpose_item(w_up + (size_t)l * DM * DFF, DM, DFF, (bf16*)(ws + WS_WGU), DFF, false, scr, r, lane); continue; } r -= I_G;
                transpose_item(w_down + (size_t)l * DFF * DM, DFF, DM, (bf16*)(ws + WS_WD), 0, false, scr, r, lane);
            }
            bf16* H = (bf16*)(ws + WS_H);
            for (int m = gw; m < M; m += NGW) { const float* mb = modl + (size_t)(m / SEQ) * NMOD;
                rms_row_to_bf16(out + (size_t)m * DM, H + (size_t)m * DM, ffn_norm + l * DM, mb + 4096, mb + 3072, lane); }
        }
#endif
        GSYNC();
#ifndef SKIP_P8
#ifdef PROBE_GEMM2
        for (int rep_ = 0; rep_ < 2; ++rep_)
#endif
        {
            unsigned char* ws = opaque_ptr(p.ws);
            pg8::Gemm g{(const bf16*)(ws + WS_H), (const bf16*)(ws + WS_WGU), DM, DM, DM, 0, 0}; pg8::StaticOrder S; S.init(M, 2 * DFF, G, bx);
            pg8::EpiBf16<0> E{(bf16*)(ws + WS_GU), 2 * DFF, nullptr, 0, 0, 1.f};
            pg8::gemm_phase<pg8::EpiBf16<0>, pg8::StaticOrder, PG8_ALIGN, PG8_SP2>(lds, g, S, E);
        }
#endif
        GSYNC();
#ifndef SKIP_P9
#ifdef PROBE_THIN2
        for (int repp9_ = 0; repp9_ < 2; ++repp9_)
#else
        const int repp9_ = 1;
#endif
        {
            PH_TID();
            bf16* GU = (bf16*)(ws + WS_GU); const float* conv_w = inptr(p, 16); const float* conv_b = inptr(p, 17);
            for (int item = bx; item < M / 64; item += G) {
                if (tid < DFF / 8) {
                    const int col = tid * 8, r0 = item * 64;
                    float cw0[8], cw1[8], cw2[8], cb[8], gm2[8], gm1[8];
#pragma unroll
                    for (int j = 0; j < 8; ++j) { cw0[j] = conv_w[(size_t)(l * 3 + 0) * DFF + col + j]; cw1[j] = conv_w[(size_t)(l * 3 + 1) * DFF + col + j]; cw2[j] = conv_w[(size_t)(l * 3 + 2) * DFF + col + j];
                        cb[j] = conv_b[(size_t)l * DFF + col + j]; gm2[j] = 0.f; gm1[j] = 0.f; }
                    if ((r0 % SEQ) != 0) {
                        const v4u a = *(const v4u*)(GU + (size_t)(r0 - 2) * (2 * DFF) + col), bq = *(const v4u*)(GU + (size_t)(r0 - 1) * (2 * DFF) + col);
                        gm2[0] = bflo(a.x); gm2[1] = bfhi(a.x); gm2[2] = bflo(a.y); gm2[3] = bfhi(a.y); gm2[4] = bflo(a.z); gm2[5] = bfhi(a.z); gm2[6] = bflo(a.w); gm2[7] = bfhi(a.w);
                        gm1[0] = bflo(bq.x); gm1[1] = bfhi(bq.x); gm1[2] = bflo(bq.y); gm1[3] = bfhi(bq.y); gm1[4] = bflo(bq.z); gm1[5] = bfhi(bq.z); gm1[6] = bflo(bq.w); gm1[7] = bfhi(bq.w);
                    }
#pragma unroll 4
                    for (int r = 0; r < 64; ++r) {
                        bf16* gp = GU + (size_t)(r0 + r) * (2 * DFF) + col;
                        const v4u gv = *(const v4u*)gp, uv = *(const v4u*)(gp + DFF);
                        float gq[8], uq[8], a[8];
                        gq[0] = bflo(gv.x); gq[1] = bfhi(gv.x); gq[2] = bflo(gv.y); gq[3] = bfhi(gv.y); gq[4] = bflo(gv.z); gq[5] = bfhi(gv.z); gq[6] = bflo(gv.w); gq[7] = bfhi(gv.w);
                        uq[0] = bflo(uv.x); uq[1] = bfhi(uv.x); uq[2] = bflo(uv.y); uq[3] = bfhi(uv.y); uq[4] = bflo(uv.z); uq[5] = bfhi(uv.z); uq[6] = bflo(uv.w); uq[7] = bfhi(uv.w);
#pragma unroll
                        for (int j = 0; j < 8; ++j) { const float gc = cb[j] + cw0[j] * gm2[j] + cw1[j] * gm1[j] + cw2[j] * gq[j]; a[j] = fast_silu(gc) * uq[j]; gm2[j] = gm1[j]; gm1[j] = gq[j]; }
                        v4u o; o.x = pk2(a[0], a[1]); o.y = pk2(a[2], a[3]); o.z = pk2(a[4], a[5]); o.w = pk2(a[6], a[7]);
                        *(v4u*)(gp + DFF) = repp9_ ? o : uv;
                    }
                }
            }
        }
#endif
        GSYNC();
#ifndef SKIP_P10
#ifdef PROBE_RES2
        for (int repp10_ = 0; repp10_ < 2; ++repp10_)
#else
        const int repp10_ = 1;
#endif
        {
            unsigned char* ws = opaque_ptr(p.ws);
            float* out = (float*)opaque_ptr(p.out);
            pg8::Gemm g{(const bf16*)(ws + WS_GU) + DFF, (const bf16*)(ws + WS_WD), 2 * DFF, DFF, DFF, 0, 0}; pg8::StaticOrder S; S.init(M, DM, G, bx);
            EpiResid E{out, out, (const float*)(ws + WS_MOD) + (size_t)l * NB * NMOD + 5120, repp10_ ? 1.f : 0.f};
            pg8::gemm_phase<EpiResid, pg8::StaticOrder, PG8_ALIGN, PG8_SP2>(lds, g, S, E);
        }
#endif
        GSYNC();
    }
    {
        PH_TID();
        float* out = (float*)opaque_ptr(p.out); const float* final_norm = inptr(p, 19);
        for (int m = gw; m < M; m += NGW) {
            f32x4* xr = (f32x4*)(out + (size_t)m * DM) + lane;
            f32x4 v[4]; float s = 0.f;
#pragma unroll
            for (int j = 0; j < 4; ++j) { v[j] = xr[64 * j]; s += (v[j].x * v[j].x + v[j].y * v[j].y) + (v[j].z * v[j].z + v[j].w * v[j].w); }
            const float rstd = 1.0f / sqrtf(wave_sum(s) * (1.f / DM) + 1e-6f);
#pragma unroll
            for (int j = 0; j < 4; ++j) xr[64 * j] = (v[j] * rstd) * ((const f32x4*)final_norm)[lane + 64 * j];
        }
    }
}

extern "C" void kernel_launch(void* const* d_in, const int* in_sizes, int n_in, void* d_out, int out_size, void* d_ws, size_t ws_size, hipStream_t stream) {
    static int grid_blocks = 0;
    if (grid_blocks == 0) {
        if (n_in != 20 || ws_size < WS_END || out_size != M * DM) { fprintf(stderr, "kernel_launch: unexpected problem (n_in %d, ws %zu, out %d)\n", n_in, ws_size, out_size); grid_blocks = -1; return; }
        int dev = 0, cus = 0, per_cu = 0;
        hipGetDevice(&dev);
        hipDeviceGetAttribute(&cus, hipDeviceAttributeMultiprocessorCount, dev);
        hipFuncSetAttribute((const void*)fwd_megakernel, hipFuncAttributeMaxDynamicSharedMemorySize, LDS_BYTES);
        hipOccupancyMaxActiveBlocksPerMultiprocessor(&per_cu, (const void*)fwd_megakernel, 512, LDS_BYTES);
        if (per_cu < 1) per_cu = 1;
        grid_blocks = cus * per_cu;
        (void)hipGetLastError();
    }
    if (grid_blocks < 0) return;
    if (hipMemsetAsync((char*)d_ws + WS_BAR, 0, 16384, stream) != hipSuccess) { fprintf(stderr, "memset failed\n"); return; }
    Params p{};
    for (int i = 0; i < 20; ++i) p.in[i] = (const float*)d_in[i];
    p.out = (float*)d_out; p.ws = (unsigned char*)d_ws;
    void* args[] = {&p};
    hipError_t e = hipLaunchCooperativeKernel((const void*)fwd_megakernel, dim3(grid_blocks), dim3(512), args, LDS_BYTES, stream);
    if (e != hipSuccess) fprintf(stderr, "cooperative launch failed: %s (grid %d)\n", hipGetErrorString(e), grid_blocks);
}
```

```cpp
#define ATT_V2 1
#include <hip/hip_runtime.h>
#include <cstdio>
#include <cstdint>
namespace pg8 {
#define PG8_LAS __attribute__((address_space(3)))
typedef unsigned short bf16_t;
typedef short bf16x8 __attribute__((ext_vector_type(8)));
typedef float f32x4 __attribute__((ext_vector_type(4)));
typedef unsigned u32x4 __attribute__((ext_vector_type(4)));
constexpr int BM = 256, BK = 64, HALF = 128, HTB = HALF * BK * 2  , STAGE_BYTES = 8 * HTB, NXCD = 8, WGM = 8;

__host__ __device__ __forceinline__ int lds_byte(int r, int c) { const int st = (r >> 4) * 2 + (c >> 5), rr = r & 15, cc = c & 31, ob = rr * 64 + cc * 2; return st * 1024 + (ob ^ (((ob >> 9) & 1) << 5)); }
__host__ __device__ __forceinline__ void stage_rc(int b, int& R, int& C) { const int st = b / 1024, sb = b % 1024, swz = sb ^ (((sb >> 9) & 1) << 5); R = (st >> 1) * 16 + swz / 64; C = (st & 1) * 32 + (swz % 64) / 2; }
__host__ __device__ __forceinline__ int perm32(int rho) { const int n = rho >> 4, i = rho & 15; return 8 * (i >> 2) + 4 * n + (i & 3); }

struct Unit { int pm, pn, br; };
struct Gemm { const bf16_t* A; const bf16_t* Bt; int lda, ldb, K; size_t abr, bbr; };

struct StaticOrder {
    int nM, nN, nwg, G, c;
    __host__ __device__ void init(int M, int N, int G_, int c_) { nM = M / BM; nN = N / BM; nwg = nM * nN; G = G_; c = c_; }
    __host__ __device__ bool next(int i, Unit& u) const {
        const long L = (long)i * G + c; if (L >= nwg) return false;
        int wgid = (int)L; { const int q = nwg / NXCD, r = nwg % NXCD, xcd = wgid % NXCD, off = wgid / NXCD; wgid = (xcd < r ? xcd * (q + 1) : r * (q + 1) + (xcd - r) * q) + off; }
        const int nig = WGM * nN, gid = wgid / nig, fm = gid * WGM, gsz = (nM - fm) < WGM ? (nM - fm) : WGM;
        u.pm = fm + ((wgid % nig) % gsz); u.pn = (wgid % nig) / gsz; u.br = 0; return true;
    }
    __device__ __forceinline__ void a_ready(const Unit&) const {}
    __device__ __forceinline__ void done(const Unit&) const {}
};

__device__ __forceinline__ unsigned cvt_pk_bf16(float lo, float hi) { unsigned r; asm volatile("v_cvt_pk_bf16_f32 %0, %1, %2" : "=v"(r) : "v"(lo), "v"(hi)); return r; }
typedef float f32x2 __attribute__((ext_vector_type(2)));
__device__ __forceinline__ f32x2 gelu_pk(f32x2 v) {
    const f32x2 av = __builtin_elementwise_abs(v), d = av * 0.2316418882f + 1.0f;
    f32x2 t; t.x = __builtin_amdgcn_rcpf(d.x); t.y = __builtin_amdgcn_rcpf(d.y);
    f32x2 q = t * 0.5307027145f + (-0.7265760135f); q = q * t + 0.7107068705f; q = q * t + (-0.142248368f); q = q * t + 0.127414796f; q = q * t;
    const f32x2 s = (v * v) * (-0.72134752044f);
    f32x2 e; e.x = __builtin_amdgcn_exp2f(s.x); e.y = __builtin_amdgcn_exp2f(s.y);
    const f32x2 m = v * (q * e), r = v - m;
    f32x2 o; o.x = v.x < 0.f ? m.x : r.x; o.y = v.y < 0.f ? m.y : r.y; return o;
}

template <int ACT  > struct EpiBf16 {
    static constexpr bool PERM = true, AFTER_DRAIN = false; static_assert(ACT == 0 || ACT == 1, "EpiBf16: ACT is 0 (none) or 1 (gelu_pk)");
    bf16_t* O; int ldc; const float* bias; int split_cols; size_t split_stride; float scale0;
    __device__ __forceinline__ void operator()(const f32x4 (&acc)[2][2][4][2], const Unit& u, int wr, int wc, int fr, int fq) const {
        const int row0 = u.pm * BM + wr * 64 + fr; int colt = u.pn * BM; bf16_t* base = O;
        float sc = 1.f; if (split_cols) { const int t = colt / split_cols; base += (size_t)t * split_stride; colt -= t * split_cols; if (t == 0) sc = scale0; }
        const int col0 = colt + wc * 32 + 8 * fq, bcol0 = u.pn * BM + wc * 32 + 8 * fq;
        f32x4 bv[2][2];
#pragma unroll
        for (int bj = 0; bj < 2; ++bj)
#pragma unroll
            for (int n = 0; n < 2; ++n) bv[bj][n] = bias ? *(const f32x4*)(bias + bcol0 + bj * HALF + 4 * n) : (f32x4){0.f, 0.f, 0.f, 0.f};
#pragma unroll
        for (int ai = 0; ai < 2; ++ai)
#pragma unroll
            for (int m = 0; m < 4; ++m) { bf16_t* rowp = base + (size_t)(row0 + ai * HALF + m * 16) * ldc + col0;
#pragma unroll
                for (int bj = 0; bj < 2; ++bj) { f32x4 v0 = acc[ai][bj][m][0] + bv[bj][0], v1 = acc[ai][bj][m][1] + bv[bj][1];
                    if (ACT == 1) { f32x2 a = gelu_pk((f32x2){v0[0], v0[1]}), b = gelu_pk((f32x2){v0[2], v0[3]}), c = gelu_pk((f32x2){v1[0], v1[1]}), d = gelu_pk((f32x2){v1[2], v1[3]});
                        v0 = (f32x4){a.x, a.y, b.x, b.y}; v1 = (f32x4){c.x, c.y, d.x, d.y}; }
                    v0 = v0 * sc; v1 = v1 * sc; u32x4 w; w.x = cvt_pk_bf16(v0[0], v0[1]); w.y = cvt_pk_bf16(v0[2], v0[3]); w.z = cvt_pk_bf16(v1[0], v1[1]); w.w = cvt_pk_bf16(v1[2], v1[3]);
                    *(u32x4*)(rowp + bj * HALF) = w; } }
    }
};
template <class Epi, class Sched, bool ALIGN_EPI = false, bool SP2 = false>
__device__ __forceinline__ void gemm_phase(PG8_LAS unsigned char* lds, const Gemm g, const Sched& S, const Epi& E) {
    int tid_ = threadIdx.x; asm volatile("" : "+v"(tid_)); const int tid = tid_, wid = __builtin_amdgcn_readfirstlane(tid >> 6), lane = tid & 63, wr = wid >> 2, wc = wid & 3, fr = lane & 15, fq = lane >> 4;
    const int K = g.K, nt = K / BK;
    unsigned voffA[2], voffB[2];
#pragma unroll
    for (int i = 0; i < 2; ++i) { int R, C; stage_rc(tid * 16 + i * 8192, R, C); const int Rb = Epi::PERM ? ((R & ~31) + perm32(R & 31)) : R;
        voffA[i] = (unsigned)(R * g.lda + C) * 2u; voffB[i] = (unsigned)(Rb * g.ldb + C) * 2u; }
    const size_t kstep = (size_t)(BK * 2);
    const size_t hstepA = (size_t)HALF * g.lda * 2, hstepB = (size_t)HALF * g.ldb * 2;
    const size_t tstepA = 2 * hstepA, tstepB = 2 * hstepB;
    const unsigned ldsw = (unsigned)wid * 1024u;
    const int aoff = lds_byte(wr * 64 + fr, fq * 8), boff = lds_byte(wc * 32 + fr, fq * 8);
#define PG8_SA(b, h) (((b) * 2 + (h)) * HTB)
#define PG8_SB(b, h) ((4 + (b) * 2 + (h)) * HTB)
#define PG8_STAGE(bufoff, gbase, voff) do { _Pragma("unroll") for (int _i = 0; _i < 2; ++_i) \
        __builtin_amdgcn_global_load_lds((const unsigned*)((const char*)(gbase) + (voff)[_i]), (PG8_LAS unsigned*)(lds + (bufoff) + ldsw + _i * 8192), 16, 0, 0); } while (0)
#define PG8_LDA(dst, b, h) do { _Pragma("unroll") for (int m = 0; m < 4; ++m) _Pragma("unroll") for (int k = 0; k < 2; ++k) dst[m][k] = *(const PG8_LAS bf16x8*)(lds + PG8_SA(b, h) + aoff + m * 2048 + k * 1024); } while (0)
#define PG8_LDB(dst, b, h) do { _Pragma("unroll") for (int n = 0; n < 2; ++n) _Pragma("unroll") for (int k = 0; k < 2; ++k) dst[n][k] = *(const PG8_LAS bf16x8*)(lds + PG8_SB(b, h) + boff + n * 2048 + k * 1024); } while (0)
#define PG8_MMA(ai, bj, At, Bt) do { __builtin_amdgcn_s_setprio(1); _Pragma("unroll") for (int m = 0; m < 4; ++m) _Pragma("unroll") for (int n = 0; n < 2; ++n) _Pragma("unroll") for (int k = 0; k < 2; ++k) \
        acc[ai][bj][m][n] = __builtin_amdgcn_mfma_f32_16x16x32_bf16(Bt[n][k], At[m][k], acc[ai][bj][m][n], 0, 0, 0); __builtin_amdgcn_s_setprio(0); } while (0)
#define PG8_WAIT_V(n) asm volatile("s_waitcnt vmcnt(" #n ")" ::: "memory")
#define PG8_WAIT_L(n) asm volatile("s_waitcnt lgkmcnt(" #n ")" ::: "memory")
#define PG8_BAR __builtin_amdgcn_s_barrier()
#define PG8_SCHED __builtin_amdgcn_sched_barrier(0)
    Unit cur, nxt; int ui = 0;
    if (!S.next(0, cur)) return;
    f32x4 acc[2][2][4][2];
#pragma unroll
    for (int a = 0; a < 2; ++a)
#pragma unroll
        for (int b = 0; b < 2; ++b)
#pragma unroll
            for (int m = 0; m < 4; ++m)
#pragma unroll
                for (int n = 0; n < 2; ++n) acc[a][b][m][n] = (f32x4){0.f, 0.f, 0.f, 0.f};
    bf16x8 At[4][2], B0[2][2], B1[2][2];
    const char* cA = (const char*)g.A + (size_t)cur.pm * tstepA + (size_t)cur.br * g.abr; const char* cB = (const char*)g.Bt + (size_t)cur.pn * tstepB + (size_t)cur.br * g.bbr;
    S.a_ready(cur);
    if constexpr (SP2) {
        PG8_STAGE(PG8_SB(0, 0), cB, voffB); PG8_STAGE(PG8_SB(0, 1), cB + hstepB, voffB); PG8_STAGE(PG8_SA(0, 0), cA, voffA); PG8_STAGE(PG8_SA(0, 1), cA + hstepA, voffA);
        if (wr == 1) PG8_BAR;
        PG8_WAIT_V(2); PG8_BAR;
        PG8_STAGE(PG8_SB(1, 0), cB + kstep, voffB); PG8_STAGE(PG8_SA(1, 0), cA + kstep, voffA); PG8_STAGE(PG8_SB(1, 1), cB + hstepB + kstep, voffB);
        PG8_WAIT_V(6); PG8_BAR;
    } else {
        PG8_STAGE(PG8_SB(0, 0), cB, voffB); PG8_STAGE(PG8_SA(0, 0), cA, voffA); PG8_STAGE(PG8_SB(0, 1), cB + hstepB, voffB); PG8_STAGE(PG8_SA(0, 1), cA + hstepA, voffA);
        if (wr == 1) PG8_BAR;
        PG8_WAIT_V(4); PG8_BAR;
        PG8_STAGE(PG8_SB(1, 0), cB + kstep, voffB); PG8_STAGE(PG8_SA(1, 0), cA + kstep, voffA); PG8_STAGE(PG8_SB(1, 1), cB + hstepB + kstep, voffB);
        PG8_WAIT_V(6); PG8_BAR;
    }
    for (;;) {
        const bool has_next = S.next(ui + 1, nxt);
        const char* nA = has_next ? (const char*)g.A + (size_t)nxt.pm * tstepA + (size_t)nxt.br * g.abr : cA; const char* nB = has_next ? (const char*)g.Bt + (size_t)nxt.pn * tstepB + (size_t)nxt.br * g.bbr : cB;
        for (int t = 0; t < nt; t += 2) {
            const bool last = (t == nt - 2);
            const char* a1 = cA + (size_t)(t + 1) * kstep;
            const char* a2 = last ? nA : cA + (size_t)(t + 2) * kstep; const char* b2 = last ? nB : cB + (size_t)(t + 2) * kstep;
            const char* a3 = a2 + kstep; const char* b3 = b2 + kstep;
            if (last && has_next) S.a_ready(nxt);
            if constexpr (SP2) {
            PG8_LDB(B0, 0, 0); PG8_LDB(B1, 0, 1); PG8_SCHED; PG8_LDA(At, 0, 0); PG8_STAGE(PG8_SA(1, 1), a1 + hstepA, voffA);
            PG8_WAIT_V(8); PG8_WAIT_L(0); PG8_BAR; PG8_MMA(0, 0, At, B0); PG8_MMA(0, 1, At, B1); PG8_BAR; PG8_SCHED;
            PG8_LDA(At, 0, 1); PG8_STAGE(PG8_SB(0, 0), b2, voffB); PG8_STAGE(PG8_SB(0, 1), b2 + hstepB, voffB); PG8_STAGE(PG8_SA(0, 0), a2, voffA);
            PG8_WAIT_V(8); PG8_WAIT_L(0); PG8_BAR; PG8_MMA(1, 0, At, B0); PG8_MMA(1, 1, At, B1); PG8_BAR; PG8_SCHED;
            PG8_LDB(B0, 1, 0); PG8_LDB(B1, 1, 1); PG8_SCHED; PG8_LDA(At, 1, 0); PG8_STAGE(PG8_SA(0, 1), a2 + hstepA, voffA);
            PG8_WAIT_V(8); PG8_WAIT_L(0); PG8_BAR; PG8_MMA(0, 0, At, B0); PG8_MMA(0, 1, At, B1); PG8_BAR; PG8_SCHED;
            PG8_LDA(At, 1, 1); PG8_STAGE(PG8_SB(1, 0), b3, voffB); PG8_STAGE(PG8_SB(1, 1), b3 + hstepB, voffB); PG8_STAGE(PG8_SA(1, 0), a3, voffA);
            PG8_WAIT_V(8); PG8_WAIT_L(0); PG8_BAR; PG8_MMA(1, 0, At, B0); PG8_MMA(1, 1, At, B1); PG8_BAR; PG8_SCHED;
            } else {
            PG8_LDB(B0, 0, 0); PG8_SCHED; PG8_LDA(At, 0, 0); PG8_STAGE(PG8_SA(1, 1), a1 + hstepA, voffA);
            PG8_WAIT_L(8); PG8_BAR; PG8_WAIT_L(0); PG8_MMA(0, 0, At, B0); PG8_BAR; PG8_SCHED;
            PG8_LDB(B1, 0, 1); PG8_STAGE(PG8_SB(0, 0), b2, voffB);
            PG8_BAR; PG8_WAIT_L(0); PG8_MMA(0, 1, At, B1); PG8_BAR;
            PG8_LDA(At, 0, 1); PG8_STAGE(PG8_SA(0, 0), a2, voffA);
            PG8_BAR; PG8_WAIT_L(0); PG8_MMA(1, 0, At, B0); PG8_BAR; PG8_SCHED;
            PG8_STAGE(PG8_SB(0, 1), b2 + hstepB, voffB);
            PG8_WAIT_V(6); PG8_BAR; PG8_MMA(1, 1, At, B1); PG8_BAR;
            PG8_LDB(B0, 1, 0); PG8_SCHED; PG8_LDA(At, 1, 0); PG8_STAGE(PG8_SA(0, 1), a2 + hstepA, voffA);
            PG8_WAIT_L(8); PG8_BAR; PG8_WAIT_L(0); PG8_MMA(0, 0, At, B0); PG8_BAR; PG8_SCHED;
            PG8_LDB(B1, 1, 1); PG8_STAGE(PG8_SB(1, 0), b3, voffB);
            PG8_BAR; PG8_WAIT_L(0); PG8_MMA(0, 1, At, B1); PG8_BAR;
            PG8_LDA(At, 1, 1); PG8_STAGE(PG8_SA(1, 0), a3, voffA);
            PG8_BAR; PG8_WAIT_L(0); PG8_MMA(1, 0, At, B0); PG8_BAR; PG8_SCHED;
            PG8_STAGE(PG8_SB(1, 1), b3 + hstepB, voffB);
            PG8_WAIT_V(6); PG8_BAR; PG8_MMA(1, 1, At, B1); PG8_BAR;
            }
        }
        if constexpr (ALIGN_EPI) { if (wr == 0) PG8_BAR; }
        if constexpr (!Epi::AFTER_DRAIN) { E(acc, cur, wr, wc, fr, fq); S.done(cur); }
        if (!has_next) break;
#pragma unroll
        for (int a = 0; a < 2; ++a)
#pragma unroll
            for (int b = 0; b < 2; ++b)
#pragma unroll
                for (int m = 0; m < 4; ++m)
#pragma unroll
                    for (int n = 0; n < 2; ++n) acc[a][b][m][n] = (f32x4){0.f, 0.f, 0.f, 0.f};
        cur = nxt; cA = nA; cB = nB; ++ui;
        if constexpr (ALIGN_EPI) { if (wr == 1) PG8_BAR; }
    }
    PG8_WAIT_V(0);
    if constexpr (!ALIGN_EPI) { if (wr == 0) PG8_BAR; }
    PG8_BAR;
    if constexpr (Epi::AFTER_DRAIN) { E.fused(acc, cur, wr, wc, fr, fq, lds, wid, lane); S.done(cur); }
#undef PG8_SA
#undef PG8_SB
#undef PG8_STAGE
#undef PG8_LDA
#undef PG8_LDB
#undef PG8_MMA
#undef PG8_WAIT_V
#undef PG8_WAIT_L
#undef PG8_BAR
#undef PG8_SCHED
}
}

#define PG8_SP2 true
#define PG8_ALIGN true

#define ATT_OFF_Q (94ull<<20)
#define ATT_OFF_K (158ull<<20)
#define ATT_OFF_V (222ull<<20)
#define ATT_OFF_O (30ull<<20)
#define ATT_OFF_SSQ (9ull<<20)
#include <hip/hip_bf16.h>
#include <cmath>
namespace attn_body {
using bf16=__hip_bfloat16;
using bf16x8=__attribute__((ext_vector_type(8)))short;
using s16x4=__attribute__((ext_vector_type(4)))short;
using f32x16=__attribute__((ext_vector_type(16)))float;
using u32x4=__attribute__((ext_vector_type(4)))unsigned;
constexpr int BATCH=4,NHEAD=16,SEQ=8192,D=64,DM=NHEAD*D;
constexpr int NW=8,QBLK=32,QB=QBLK*NW,KVBLK=64,NQB=SEQ/QB;
constexpr int ATTN_PITCH=DM, ATTN_UNIT_ROWS=QB;
__device__ __forceinline__ int crow(int r,int hi){return (r&3)+8*(r>>2)+4*hi;}
#define SBAR() __builtin_amdgcn_sched_barrier(0)
__device__ __forceinline__ void cmask(f32x16&p0,f32x16&p1,int jb,int qrel,int hi){
  const float NEG=-INFINITY; int kb=64*jb+4*hi;
  #pragma unroll
  for(int r=0;r<16;++r){int kv=kb+(r&3)+8*(r>>2); if(kv>qrel)p0[r]=NEG; if(kv+32>qrel)p1[r]=NEG;}
}

constexpr int NSLOT=3, SLOTB=8192;
constexpr int LDS_K=0, LDS_V=NSLOT*SLOTB, LDS_WS=3*NSLOT*SLOTB, LDS_OST=LDS_WS+NW*64*4, LDS_BYTES=LDS_OST+NW*8192;
constexpr float C2=0.125f*1.4426950408889634f;
__device__ __forceinline__ void glds16(const void*gsrc,unsigned lds_dst){unsigned keep;
  asm volatile("s_mov_b32 %0, m0\n\ts_mov_b32 m0, %2\n\ts_nop 0\n\tglobal_load_lds_dwordx4 %1, off\n\ts_mov_b32 m0, %0":"=&s"(keep):"v"(gsrc),"s"(lds_dst):"memory");}
__device__ __forceinline__ float bpx(float v,int m,int lane){return __uint_as_float(__builtin_amdgcn_ds_bpermute((lane^m)<<2,__float_as_uint(v)));}
__device__ __forceinline__ float max3f(float a,float b,float c){float r;asm("v_max3_f32 %0, %1, %2, %3":"=v"(r):"v"(a),"v"(b),"v"(c));return r;}
__device__ __forceinline__ float max2f(float a,float b){float r;asm("v_max_f32_e32 %0, %1, %2":"=v"(r):"v"(a),"v"(b));return r;}
__device__ __forceinline__ float fadd_s(float a,float b){float r;asm("v_add_f32_e32 %0, %1, %2":"=v"(r):"v"(a),"v"(b));return r;}
__device__ __forceinline__ float fsub_s(float a,float b){float r;asm("v_sub_f32_e32 %0, %1, %2":"=v"(r):"v"(a),"v"(b));return r;}
typedef float f32x2_t __attribute__((ext_vector_type(2))); typedef __bf16 bf16x2_t __attribute__((ext_vector_type(2)));
__device__ __forceinline__ unsigned cvtpk_s(float lo,float hi){f32x2_t v={lo,hi};bf16x2_t b=__builtin_convertvector(v,bf16x2_t);return __builtin_bit_cast(unsigned,b);}
#define WAIT_BAR(N) asm volatile("s_waitcnt vmcnt(" #N ") lgkmcnt(0)\n\ts_barrier":::"memory")

__device__ __forceinline__ void qkt(f32x16&p0,f32x16&p1,const char*Kslot,const bf16x8*qr,const f32x16&negm,int r32,int hi){
  const char*kb=Kslot+hi*1024+r32*16;
  #pragma unroll
  for(int d0=0;d0<4;++d0){
    const bf16x8 b0=*reinterpret_cast<const bf16x8*>(kb+d0*2048);
    const bf16x8 b1=*reinterpret_cast<const bf16x8*>(kb+d0*2048+512);
    if(d0==0){p0=__builtin_amdgcn_mfma_f32_32x32x16_bf16(b0,qr[0],negm,0,0,0);p1=__builtin_amdgcn_mfma_f32_32x32x16_bf16(b1,qr[0],negm,0,0,0);}
    else{p0=__builtin_amdgcn_mfma_f32_32x32x16_bf16(b0,qr[d0],p0,0,0,0);p1=__builtin_amdgcn_mfma_f32_32x32x16_bf16(b1,qr[d0],p1,0,0,0);}}
}
typedef __attribute__((address_space(3))) const char* lds_cptr;
typedef short v4i16_t __attribute__((ext_vector_type(4)));
__device__ __forceinline__ void kload8(bf16x8*kf,lds_cptr kp){
  kf[0]=*(const __attribute__((address_space(3))) bf16x8*)(kp);      kf[1]=*(const __attribute__((address_space(3))) bf16x8*)(kp+512);
  kf[2]=*(const __attribute__((address_space(3))) bf16x8*)(kp+2048); kf[3]=*(const __attribute__((address_space(3))) bf16x8*)(kp+2560);
  kf[4]=*(const __attribute__((address_space(3))) bf16x8*)(kp+4096); kf[5]=*(const __attribute__((address_space(3))) bf16x8*)(kp+4608);
  kf[6]=*(const __attribute__((address_space(3))) bf16x8*)(kp+6144); kf[7]=*(const __attribute__((address_space(3))) bf16x8*)(kp+6656);
}
__device__ __forceinline__ void kload2(bf16x8*kf,lds_cptr kp,int j){ kf[2*j]=*(const __attribute__((address_space(3))) bf16x8*)(kp+j*2048); kf[2*j+1]=*(const __attribute__((address_space(3))) bf16x8*)(kp+j*2048+512); }
__device__ __forceinline__ s16x4 vtr(lds_cptr p){ return __builtin_bit_cast(s16x4,__builtin_amdgcn_ds_read_tr16_b64_v4i16((__attribute__((address_space(3))) v4i16_t*)p)); }
__device__ __forceinline__ float rowmax(const f32x16&p0,const f32x16&p1){
  float a=max3f(p0[0],p0[1],p1[0]),b=max3f(p0[2],p0[3],p1[1]);a=max3f(a,p1[2],p1[3]);
  #pragma unroll
  for(int r=4;r<16;r+=4){a=max3f(a,p0[r],p0[r+1]);b=max3f(b,p0[r+2],p0[r+3]);a=max3f(a,p1[r],p1[r+1]);b=max3f(b,p1[r+2],p1[r+3]);}
  const float m=max2f(a,b);
  auto rr=__builtin_amdgcn_permlane32_swap(__float_as_uint(m),__float_as_uint(m),false,false);
  return max2f(__uint_as_float(rr[0]),__uint_as_float(rr[1]));
}
__device__ __forceinline__ void pv(f32x16*o,int vb,bf16x8 pa0,bf16x8 pa1,bf16x8 pa2,bf16x8 pa3){
  #pragma unroll
  for(int d0=0;d0<4;++d0){s16x4 lo[4],hi[4];
    #pragma unroll
    for(int ks=0;ks<4;++ks){
      asm volatile("ds_read_b64_tr_b16 %0,%1 offset:%c2":"=&v"(lo[ks]):"v"(vb),"i"(d0*4096+ks*1024):"memory");
      asm volatile("ds_read_b64_tr_b16 %0,%1 offset:%c2":"=&v"(hi[ks]):"v"(vb),"i"(d0*4096+ks*1024+512):"memory");}
    asm volatile("s_waitcnt lgkmcnt(0)":::"memory");SBAR();
    #define PK(k) (bf16x8){lo[k][0],lo[k][1],lo[k][2],lo[k][3],hi[k][0],hi[k][1],hi[k][2],hi[k][3]}
    o[d0]=__builtin_amdgcn_mfma_f32_32x32x16_bf16(pa0,PK(0),o[d0],0,0,0);
    o[d0]=__builtin_amdgcn_mfma_f32_32x32x16_bf16(pa1,PK(1),o[d0],0,0,0);
    o[d0]=__builtin_amdgcn_mfma_f32_32x32x16_bf16(pa2,PK(2),o[d0],0,0,0);
    o[d0]=__builtin_amdgcn_mfma_f32_32x32x16_bf16(pa3,PK(3),o[d0],0,0,0);
    #undef PK
  }
}

#ifndef ATTN_STORE16
#define ATTN_STORE16(p,v) (*(u32x4*)(p)=(v))
#endif
template<int THRL> __device__ __forceinline__ void attn_unit(int b,int h,int hv,int qb,const unsigned char*wsb,char*shm,int mode,float lam,const float*gsub,float onem){ const bf16*Q=(const bf16*)(wsb+ATT_OFF_Q); const bf16*__restrict__ K=(const bf16*)(wsb+ATT_OFF_K); const bf16*__restrict__ V=(const bf16*)(wsb+ATT_OFF_V);
  int tid=threadIdx.x; asm volatile("":"+v"(tid)); const int lane=tid&63,r32=lane&31,hi=lane>>5; const int wid=__builtin_amdgcn_readfirstlane(tid>>6);
  const long rowbase=(long)b*SEQ; const int q0=qb*QB;
  const bf16*Qw=Q+(rowbase+q0+wid*QBLK)*DM+h*D;
  const bf16*Kh=K+rowbase*DM+h*D,*Vh=V+rowbase*DM+hv*128;
  const unsigned lds0=(unsigned)(uintptr_t)shm;
  float*wsf=(float*)(shm+LDS_WS)+wid*64;
  const bf16*ksrc=Kh+(long)lane*DM+wid*8;
  const bf16*vsrc=Vh+(long)(16*(wid&3)+(lane>>2))*DM+(wid>>2)*32+(lane&3)*8;
  const unsigned kdst=lds0+LDS_K+wid*1024, vdst=lds0+LDS_V+wid*1024;
  #define DMA_K(t,slot) glds16(ksrc+(long)(t)*KVBLK*DM,(unsigned)__builtin_amdgcn_readfirstlane(kdst+(slot)))
  #define DMA_V(t,slot) do{ glds16(vsrc+(long)(t)*KVBLK*DM,(unsigned)__builtin_amdgcn_readfirstlane(vdst+2*(slot))); glds16(vsrc+(long)(t)*KVBLK*DM+64,(unsigned)__builtin_amdgcn_readfirstlane(vdst+2*(slot)+8192)); }while(0)
  const int vb0=(int)(lds0+LDS_V)+((lane>>4)&1)*32+(lane&3)*8+(4*hi+((lane&15)>>2))*64;
  const char*Kbase=shm+LDS_K; bf16x8 kf[8];
  const lds_cptr shm3=(lds_cptr)shm; const lds_cptr kp0=shm3+LDS_K+hi*1024+r32*16; const lds_cptr vp0=shm3+LDS_V+((lane>>4)&1)*32+(lane&3)*8+(4*hi+((lane&15)>>2))*64;
  const int NT=(q0+QB)/KVBLK;
  DMA_K(0,0);DMA_V(0,0);DMA_K(1,SLOTB);
  bf16x8 qr[4];
  #pragma unroll
  for(int d0=0;d0<4;++d0)qr[d0]=*reinterpret_cast<const bf16x8*>(&Qw[(long)r32*DM+d0*16+hi*8]);
  float mhat=0.f,l_reg=0.f;float z_=0.f; asm volatile("":"+v"(z_)); f32x16 zz_; _Pragma("unroll") for(int r=0;r<16;++r)zz_[r]=z_; f32x16 o[4];o[0]=zz_;o[1]=zz_;o[2]=zz_;o[3]=zz_;f32x16 negm=zz_;asm volatile("":"+v"(negm));
  const int qrel=wid*QBLK+r32;
  #define CMASK(P0,P1,t) do{int jb_=(t)-(NT-4); if(jb_>=0)cmask(P0,P1,jb_,qrel,hi);}while(0)
  bool resc=false;
  #define START(P0,P1) do{ const float rm=rowmax(P0,P1); resc=false; \
    { const float dl=rm; mhat=fadd_s(mhat,dl); \
      _Pragma("unroll") for(int r=0;r<16;++r){P0[r]=fsub_s(P0[r],dl);P1[r]=fsub_s(P1[r],dl);} \
      _Pragma("unroll") for(int r=0;r<16;++r)negm[r]=-mhat; asm volatile("":"+v"(negm)); } \
    _Pragma("unroll") for(int r=0;r<16;++r)P0[r]=__builtin_amdgcn_exp2f(P0[r]); }while(0)
  #define RESC() do{ if(resc){ asm volatile("s_waitcnt lgkmcnt(0)":::"memory"); \
      _Pragma("unroll") for(int d_=0;d_<4;++d_) _Pragma("unroll") for(int r=0;r<16;++r)o[d_][r]*=wsf[crow(r,hi)]; } }while(0)
  f32x16 pA0,pA1,pB0,pB1;
  int sl_prev=0,sl_cur=0,sl_next=SLOTB;
  #define ROT() do{sl_prev=sl_cur;sl_cur=sl_next;sl_next=(sl_next==(NSLOT-1)*SLOTB)?0:sl_next+SLOTB;}while(0)
  DMA_K(2,2*SLOTB);
  WAIT_BAR(4);
  qkt(pA0,pA1,Kbase,qr,negm,r32,hi);asm volatile("s_nop 15\n\ts_nop 7":"+v"(pA0),"+v"(pA1));CMASK(pA0,pA1,0);
  START(pA0,pA1);
  _Pragma("unroll") for(int r=0;r<16;++r)pA1[r]=__builtin_amdgcn_exp2f(pA1[r]);
  WAIT_BAR(0);
  DMA_K(3,0);DMA_V(1,SLOTB);
  ROT();
  kload8(kf,kp0+sl_cur);
  WAIT_BAR(3);
  s16x4 vlo[8],vhi[8]; u32x4 pw0,pw1,pw2,pw3;
  #define PKW(P,B) cvtpk_s(P[B],P[B+1])
  #define PAF(k) __builtin_bit_cast(bf16x8,pw##k)
  #define VFR(i) (bf16x8){vlo[i][0],vlo[i][1],vlo[i][2],vlo[i][3],vhi[i][0],vhi[i][1],vhi[i][2],vhi[i][3]}
  #define PIN(x) asm volatile("":"+v"(x))
  #define MX3(a,b,c) __builtin_fmaxf(__builtin_fmaxf((a),(b)),(c))
  #define GAPA(MF,A0,A1,A2,A3,W0,W1,PW) do{ MF; sacc+=A0; sacc+=A1; sacc+=A2; sacc+=A3; PIN(sacc); W0; W1; PIN(PW); SBAR(); }while(0)
  #define EX(v) __builtin_amdgcn_exp2f(v)
  #define GAPB(MF,X,B) do{ MF; X[B]=EX(X[B]); X[B+1]=EX(X[B+1]); X[B+2]=EX(X[B+2]); X[B+3]=EX(X[B+3]); PIN(X); SBAR(); }while(0)
  #define VRD(i) do{ vlo[(i)&7]=vtr(vp_+(((i)>>2)*4096+((i)&3)*1024)); vhi[(i)&7]=vtr(vp_+(((i)>>2)*4096+((i)&3)*1024+512)); }while(0)
  #define GAPB2(MF,X,B) do{ MF; X[B]=EX(X[B]); X[B+1]=EX(X[B+1]); PIN(X); SBAR(); }while(0)
  #define KRD(G,j) do{ if(G){ kload2(kf,kp0+sl_next,j); SBAR(); } }while(0)
  #define STEP(C0,C1,P0,P1,t,GK,GV,GL) do{ SBAR(); \
    const lds_cptr vp_=vp0+2*sl_prev; \
    VRD(0); SBAR(); float sacc=(P0[0]+P0[1]); \
    GAPA(C0=__builtin_amdgcn_mfma_f32_32x32x16_bf16(kf[0],qr[0],negm,0,0,0), P0[2],P0[3],P0[4],P0[5],     pw0[0]=PKW(P0,0), pw0[1]=PKW(P0,2), pw0); \
    VRD(4); SBAR(); GAPA(C1=__builtin_amdgcn_mfma_f32_32x32x16_bf16(kf[1],qr[0],negm,0,0,0), P0[6],P0[7],P0[8],P0[9],     pw0[2]=PKW(P0,4), pw0[3]=PKW(P0,6), pw0); \
    VRD(1); SBAR(); GAPA(C0=__builtin_amdgcn_mfma_f32_32x32x16_bf16(kf[2],qr[1],C0,0,0,0),   P0[10],P0[11],P0[12],P0[13], pw1[0]=PKW(P0,8), pw1[1]=PKW(P0,10), pw1); \
    VRD(5); SBAR(); GAPA(C1=__builtin_amdgcn_mfma_f32_32x32x16_bf16(kf[3],qr[1],C1,0,0,0),   P0[14],P0[15],P1[0],P1[1],   pw1[2]=PKW(P0,12),pw1[3]=PKW(P0,14), pw1); \
    GAPA(C0=__builtin_amdgcn_mfma_f32_32x32x16_bf16(kf[4],qr[2],C0,0,0,0),   P1[2],P1[3],P1[4],P1[5],     pw2[0]=PKW(P1,0), pw2[1]=PKW(P1,2), pw2); \
    GAPA(C1=__builtin_amdgcn_mfma_f32_32x32x16_bf16(kf[5],qr[2],C1,0,0,0),   P1[6],P1[7],P1[8],P1[9],     pw2[2]=PKW(P1,4), pw2[3]=PKW(P1,6), pw2); \
    GAPA(C0=__builtin_amdgcn_mfma_f32_32x32x16_bf16(kf[6],qr[3],C0,0,0,0),   P1[10],P1[11],P1[12],P1[13], pw3[0]=PKW(P1,8), pw3[1]=PKW(P1,10), pw3); \
    GAPA(C1=__builtin_amdgcn_mfma_f32_32x32x16_bf16(kf[7],qr[3],C1,0,0,0),   P1[14],P1[15],0.f,0.f,       pw3[2]=PKW(P1,12),pw3[3]=PKW(P1,14), pw3); \
    l_reg+=sacc; \
    if(GK){DMA_K((t)+3,sl_cur);} if(GV){DMA_V((t)+1,sl_next);} \
    CMASK(C0,C1,t); \
    { float a=MX3(C0[0],C0[1],C1[0]),b=MX3(C0[2],C0[3],C1[1]); a=MX3(a,C1[2],C1[3]); \
      _Pragma("unroll") for(int r=4;r<16;r+=4){a=MX3(a,C0[r],C0[r+1]);b=MX3(b,C0[r+2],C0[r+3]);a=MX3(a,C1[r],C1[r+1]);b=MX3(b,C1[r+2],C1[r+3]);} \
      float rm=__builtin_fmaxf(a,b); { auto rr=__builtin_amdgcn_permlane32_swap(__float_as_uint(rm),__float_as_uint(rm),false,false); rm=__builtin_fmaxf(__uint_as_float(rr[0]),__uint_as_float(rr[1])); } \
      resc=false; \
      if(__builtin_expect(__any(rm>(float)THRL),0)){ const float dl=__builtin_fmaxf(rm,0.f); mhat+=dl; \
        _Pragma("unroll") for(int r=0;r<16;++r){C0[r]-=dl;C1[r]-=dl;} \
        _Pragma("unroll") for(int r=0;r<16;++r)negm[r]=-mhat; asm volatile("":"+v"(negm)); \
        const float f=__builtin_amdgcn_exp2f(-dl); l_reg*=f; if(hi==0)wsf[r32]=f; resc=true; } } \
    SBAR(); \
    VRD(2); VRD(6); SBAR(); \
    GAPB2(o[0]=__builtin_amdgcn_mfma_f32_32x32x16_bf16(PAF(0),VFR(0),o[0],0,0,0), C0,0); VRD(3); SBAR(); \
    GAPB2(o[1]=__builtin_amdgcn_mfma_f32_32x32x16_bf16(PAF(0),VFR(4),o[1],0,0,0), C0,2); VRD(7); SBAR(); \
    KRD(GL,0); GAPB2(o[0]=__builtin_amdgcn_mfma_f32_32x32x16_bf16(PAF(1),VFR(1),o[0],0,0,0), C0,4); VRD(8); SBAR(); \
    KRD(GL,1); GAPB2(o[1]=__builtin_amdgcn_mfma_f32_32x32x16_bf16(PAF(1),VFR(5),o[1],0,0,0), C0,6); VRD(12); SBAR(); \
    KRD(GL,2); GAPB2(o[0]=__builtin_amdgcn_mfma_f32_32x32x16_bf16(PAF(2),VFR(2),o[0],0,0,0), C0,8); VRD(9); SBAR(); \
    KRD(GL,3); GAPB2(o[1]=__builtin_amdgcn_mfma_f32_32x32x16_bf16(PAF(2),VFR(6),o[1],0,0,0), C0,10); VRD(13); SBAR(); \
    GAPB2(o[0]=__builtin_amdgcn_mfma_f32_32x32x16_bf16(PAF(3),VFR(3),o[0],0,0,0), C0,12); VRD(10); SBAR(); \
    GAPB2(o[1]=__builtin_amdgcn_mfma_f32_32x32x16_bf16(PAF(3),VFR(7),o[1],0,0,0), C0,14); VRD(14); SBAR(); \
    GAPB2(o[2]=__builtin_amdgcn_mfma_f32_32x32x16_bf16(PAF(0),VFR(0),o[2],0,0,0), C1,0); VRD(11); SBAR(); \
    GAPB2(o[3]=__builtin_amdgcn_mfma_f32_32x32x16_bf16(PAF(0),VFR(4),o[3],0,0,0), C1,2); VRD(15); SBAR(); \
    GAPB2(o[2]=__builtin_amdgcn_mfma_f32_32x32x16_bf16(PAF(1),VFR(1),o[2],0,0,0), C1,4); \
    GAPB2(o[3]=__builtin_amdgcn_mfma_f32_32x32x16_bf16(PAF(1),VFR(5),o[3],0,0,0), C1,6); \
    GAPB2(o[2]=__builtin_amdgcn_mfma_f32_32x32x16_bf16(PAF(2),VFR(2),o[2],0,0,0), C1,8); \
    GAPB2(o[3]=__builtin_amdgcn_mfma_f32_32x32x16_bf16(PAF(2),VFR(6),o[3],0,0,0), C1,10); \
    GAPB2(o[2]=__builtin_amdgcn_mfma_f32_32x32x16_bf16(PAF(3),VFR(3),o[2],0,0,0), C1,12); \
    GAPB2(o[3]=__builtin_amdgcn_mfma_f32_32x32x16_bf16(PAF(3),VFR(7),o[3],0,0,0), C1,14); \
    }while(0)
  int t=1;
  #undef CMASK
  #define CMASK(P0,P1,t) do{}while(0)
  for(;t+5<NT;t+=2){
    STEP(pB0,pB1,pA0,pA1,t,true,true,true);     WAIT_BAR(3); RESC(); ROT();
    STEP(pA0,pA1,pB0,pB1,t+1,true,true,true);   WAIT_BAR(3); RESC(); ROT();
  }
  #undef CMASK
  #define CMASK(P0,P1,t) do{int jb_=(t)-(NT-4); if(jb_>=0)cmask(P0,P1,jb_,qrel,hi);}while(0)
  #define ENDW(tt) do{ if((tt)+3<NT){WAIT_BAR(3);} else if((tt)+2<NT){WAIT_BAR(2);} else {WAIT_BAR(0);} }while(0)
  for(;t+1<NT;t+=2){
    STEP(pB0,pB1,pA0,pA1,t,(t+3<NT),(t+1<NT),(t+1<NT));       ENDW(t);   RESC(); ROT();
    STEP(pA0,pA1,pB0,pB1,t+1,(t+4<NT),(t+2<NT),(t+2<NT));     ENDW(t+1); RESC(); ROT();
  }
  STEP(pB0,pB1,pA0,pA1,NT-1,false,false,false); RESC();
  { float sacc=pB0[0]+pB0[1]; _Pragma("unroll") for(int r=2;r<16;++r)sacc+=pB0[r]; _Pragma("unroll") for(int r=0;r<16;++r)sacc+=pB1[r]; l_reg+=sacc;
    pw0=(u32x4){PKW(pB0,0),PKW(pB0,2),PKW(pB0,4),PKW(pB0,6)};pw1=(u32x4){PKW(pB0,8),PKW(pB0,10),PKW(pB0,12),PKW(pB0,14)};pw2=(u32x4){PKW(pB1,0),PKW(pB1,2),PKW(pB1,4),PKW(pB1,6)};pw3=(u32x4){PKW(pB1,8),PKW(pB1,10),PKW(pB1,12),PKW(pB1,14)};
    SBAR(); pv(o,vb0+2*sl_cur,PAF(0),PAF(1),PAF(2),PAF(3)); }
  #undef PKW
  #undef PAF
  #undef VFR
  #undef PIN
  #undef MX3
  #undef GAPA
  #undef GAPB
  #undef GAPB2
  #undef EX
  #undef VRD
  #undef KRD
  #undef STEP
  #undef ENDW
  {auto rr=__builtin_amdgcn_permlane32_swap(__float_as_uint(l_reg),__float_as_uint(l_reg),false,false);l_reg=__uint_as_float(rr[0])+__uint_as_float(rr[1]);}
  if(hi==0)wsf[32+r32]=l_reg;asm volatile("s_waitcnt lgkmcnt(0)":::"memory");
  float rli[16];
  #pragma unroll
  for(int r=0;r<16;++r)rli[r]=__builtin_amdgcn_rcpf(wsf[32+crow(r,hi)]);
  float*tmp=(float*)(const_cast<unsigned char*>(wsb)+ATT_OFF_O)+((size_t)(blockIdx.x*NW+wid)*64)*64+lane;
  if(mode==0){
    #pragma unroll
    for(int d0=0;d0<4;++d0){
      #pragma unroll
      for(int r=0;r<16;++r)tmp[(d0*16+r)*64]=o[d0][r]*rli[r];}
  }else{
    float ss[16];
    #pragma unroll
    for(int r=0;r<16;++r){ float a=0.f;
      #pragma unroll
      for(int d0=0;d0<4;++d0){const float dv=tmp[(d0*16+r)*64]-lam*(o[d0][r]*rli[r]); o[d0][r]=dv; a+=dv*dv;}
      ss[r]=a;}
    #pragma unroll
    for(int r=0;r<16;++r){ float a=ss[r]; a+=bpx(a,1,lane);a+=bpx(a,2,lane);a+=bpx(a,4,lane);a+=bpx(a,8,lane);a+=bpx(a,16,lane); ss[r]=onem*__builtin_amdgcn_rsqf(a*(1.0f/128.0f)+1e-5f);}
    const float g0=gsub[r32],g1=gsub[32+r32],g2=gsub[64+r32],g3=gsub[96+r32];
    bf16*Ow=const_cast<bf16*>(Q)+(rowbase+q0+wid*QBLK)*DM+hv*128;
    bf16*stg=(bf16*)(shm+LDS_OST)+wid*4096;
    #pragma unroll
    for(int r=0;r<16;++r){const int orow=crow(r,hi);
      stg[orow*128+r32]=__float2bfloat16(o[0][r]*ss[r]*g0); stg[orow*128+32+r32]=__float2bfloat16(o[1][r]*ss[r]*g1);
      stg[orow*128+64+r32]=__float2bfloat16(o[2][r]*ss[r]*g2); stg[orow*128+96+r32]=__float2bfloat16(o[3][r]*ss[r]*g3);}
    asm volatile("s_waitcnt lgkmcnt(0)":::"memory");
    #pragma unroll
    for(int i=0;i<8;++i){const int row=i*4+(lane>>4),ch=lane&15; const u32x4 v=*(const u32x4*)(stg+row*128+ch*8); ATTN_STORE16(Ow+(long)row*DM+ch*8,v);}
  }
  asm volatile("s_waitcnt lgkmcnt(0)\n\ts_barrier":::"memory");
  #undef DMA_K
  #undef DMA_V
  #undef CMASK
  #undef START
  #undef RESC
  #undef ROT
}
constexpr int ATTN_LDS_BYTES=LDS_BYTES;
#undef SBAR
#undef WAIT_BAR
}

#include <hip/hip_cooperative_groups.h>
namespace cg = cooperative_groups;
#define LAS __attribute__((address_space(3)))
typedef unsigned short bf16;
typedef unsigned v4u __attribute__((ext_vector_type(4)));
typedef float f32x4 __attribute__((ext_vector_type(4)));
typedef short bf16x8 __attribute__((ext_vector_type(8)));
typedef float f32x16 __attribute__((ext_vector_type(16)));
typedef short s16x4 __attribute__((ext_vector_type(4)));

constexpr int NB = 4, SEQ = 8192, M = NB * SEQ, DM = 1024, DEPTH = 4, INW = 6656, DFF = 2816, NMOD = 6 * DM;
constexpr float C2 = 0.125f * 1.4426950408889634f;
constexpr float LOG2E = 1.4426950408889634f;
constexpr size_t MiB = 1u << 20;
constexpr size_t WS_BAR = 0;
constexpr size_t WS_MOD = 512 * 1024;
constexpr size_t WS_ROPE = 1 * MiB;
constexpr size_t WS_SSQ = 9 * MiB;
constexpr size_t WS_WIN = 11 * MiB;
constexpr size_t WS_WA = 24 * MiB, WS_WB = 26 * MiB, WS_WO = 28 * MiB;
constexpr size_t WS_H = 30 * MiB;
constexpr size_t WS_PROJ = 94 * MiB;
constexpr size_t WS_QA = WS_PROJ, WS_KA = WS_QA + 64 * MiB, WS_VA = WS_KA + 64 * MiB, WS_QS = WS_VA + 64 * MiB, WS_KS = WS_QS + 64 * MiB, WS_VS = WS_KS + 16 * MiB, WS_GATES = WS_VS + 16 * MiB;
constexpr size_t WS_GU = WS_PROJ;
constexpr size_t WS_MIXED = WS_KA;
constexpr size_t WS_WGU = WS_PROJ + 352 * MiB;
constexpr size_t WS_WD = WS_WGU + 11 * MiB;
constexpr size_t WS_END = WS_GATES + 128 * MiB;
static_assert(WS_END == 510 * MiB && WS_WD + (size_t)DM * DFF * 2 <= WS_END && WS_GU + (size_t)M * 2 * DFF * 2 <= WS_WGU, "ws map");
constexpr int LDS_BYTES = 155648;

struct Params { const float* in[20]; float* out; unsigned char* ws; };

__device__ __forceinline__ int opaque_tid() { int t = threadIdx.x; asm volatile("" : "+v"(t)); return t; }
typedef const __attribute__((address_space(4))) unsigned char* kernarg_cptr;
__device__ __forceinline__ unsigned long long ld_karg(int off) { kernarg_cptr ka = (kernarg_cptr)__builtin_amdgcn_kernarg_segment_ptr(); return *(volatile const __attribute__((address_space(4))) unsigned long long*)(ka + off); }
__device__ __forceinline__ unsigned char* ld_ws() { return (unsigned char*)ld_karg(168); }
__device__ __forceinline__ float* ld_out() { return (float*)ld_karg(160); }
__device__ __forceinline__ float shflx(float v, int mask, int lane) { return __uint_as_float(__builtin_amdgcn_ds_bpermute((lane ^ mask) << 2, __float_as_uint(v))); }
__device__ __forceinline__ float wave_sum_l(float v, int lane) {
#pragma unroll
    for (int o = 1; o < 64; o <<= 1) v += shflx(v, o, lane);
    return v;
}
__device__ __forceinline__ const float* inptr(const Params& p, int k) { asm volatile("" : "+s"(k)); return p.in[k]; }
static_assert(sizeof(Params) == 176, "kernarg offsets");
static_assert(WS_QA == ATT_OFF_Q && WS_KA == ATT_OFF_K && WS_VA == ATT_OFF_V && WS_H == ATT_OFF_O && WS_SSQ == ATT_OFF_SSQ, "attention workspace offsets");

__device__ __forceinline__ unsigned f2bf(float f) { unsigned u = __builtin_bit_cast(unsigned, f); return (u + 0x7fffu + ((u >> 16) & 1u)) >> 16; }
__device__ __forceinline__ unsigned pk2(float lo, float hi) { typedef float f2 __attribute__((ext_vector_type(2))); typedef __bf16 b2 __attribute__((ext_vector_type(2))); f2 v = {lo, hi}; b2 b = __builtin_convertvector(v, b2); return __builtin_bit_cast(unsigned, b); }
__device__ __forceinline__ float bflo(unsigned w) { return __uint_as_float(w << 16); }
__device__ __forceinline__ float bfhi(unsigned w) { return __uint_as_float(w & 0xffff0000u); }
__device__ __forceinline__ float wave_sum(float v) {
#pragma unroll
    for (int o = 1; o < 64; o <<= 1) v += __shfl_xor(v, o);
    return v;
}
__device__ __forceinline__ float fast_sigmoid(float x) { return __builtin_amdgcn_rcpf(1.0f + __builtin_amdgcn_exp2f(-x * LOG2E)); }
__device__ __forceinline__ float fast_silu(float x) { return x * fast_sigmoid(x); }
__device__ __forceinline__ float lambda_init_of(int l) { return l == 0 ? 0.2f : l == 1 ? 0.35550906759096926f : l == 2 ? 0.47071301834358413f : 0.5560582041564726f; }

struct EpiIn {
    static constexpr bool PERM = true, AFTER_DRAIN = false;
    unsigned char* ws; const float* rope;
    __device__ __forceinline__ void operator()(const pg8::f32x4 (&acc)[2][2][4][2], const pg8::Unit& u, int wr, int wc, int fr, int fq) const {
        const int pn = u.pn; bf16* base; int ld, kind;
        if (pn < 4)        { base = (bf16*)(ws + WS_QA) + pn * 256;        ld = 1024; kind = 0; }
        else if (pn < 8)   { base = (bf16*)(ws + WS_KA) + (pn - 4) * 256;  ld = 1024; kind = 1; }
        else if (pn < 12)  { base = (bf16*)(ws + WS_VA) + (pn - 8) * 256;  ld = 1024; kind = 2; }
        else if (pn < 16)  { base = (bf16*)(ws + WS_QS) + (pn - 12) * 256; ld = 1024; kind = 0; }
        else if (pn == 16) { base = (bf16*)(ws + WS_KS);                   ld = 256;  kind = 1; }
        else if (pn == 17) { base = (bf16*)(ws + WS_VS);                   ld = 256;  kind = 2; }
        else               { base = (bf16*)(ws + WS_GATES) + (pn - 18) * 256; ld = 2048; kind = 3; }
        const int row0 = u.pm * 256 + wr * 64 + fr, colp = 64 * wc + 8 * fq;
#pragma unroll
        for (int ai = 0; ai < 2; ++ai)
#pragma unroll
            for (int m = 0; m < 4; ++m) {
                const int row = row0 + ai * 128 + m * 16;
                pg8::f32x4 a0 = acc[ai][0][m][0], a1 = acc[ai][0][m][1], b0 = acc[ai][1][m][0], b1 = acc[ai][1][m][1];
                if (kind <= 1) {
                    const float* rp = rope + (size_t)row * 64 + 8 * fq;
                    const pg8::f32x4 c0 = *(const pg8::f32x4*)rp, c1 = *(const pg8::f32x4*)(rp + 4), s0 = *(const pg8::f32x4*)(rp + 32), s1 = *(const pg8::f32x4*)(rp + 36);
                    const pg8::f32x4 o1a = a0 * c0 - b0 * s0, o1b = a1 * c1 - b1 * s1, o2a = b0 * c0 + a0 * s0, o2b = b1 * c1 + a1 * s1;
                    const float sc = (kind == 0) ? C2 : 1.0f;
                    a0 = o1a * sc; a1 = o1b * sc; b0 = o2a * sc; b1 = o2b * sc;
                } else if (kind == 3) {
#pragma unroll
                    for (int i = 0; i < 4; ++i) { a0[i] = fast_sigmoid(a0[i]); a1[i] = fast_sigmoid(a1[i]); b0[i] = fast_sigmoid(b0[i]); b1[i] = fast_sigmoid(b1[i]); }
                }
                pg8::u32x4 w1, w2;
                w1.x = pk2(a0[0], a0[1]); w1.y = pk2(a0[2], a0[3]); w1.z = pk2(a1[0], a1[1]); w1.w = pk2(a1[2], a1[3]);
                w2.x = pk2(b0[0], b0[1]); w2.y = pk2(b0[2], b0[3]); w2.z = pk2(b1[0], b1[1]); w2.w = pk2(b1[2], b1[3]);
                bf16* rowp = base + (size_t)row * ld + colp;
                *(pg8::u32x4*)rowp = w1; *(pg8::u32x4*)(rowp + 32) = w2;
            }
    }
};
struct EpiBranch {
    static constexpr bool PERM = true, AFTER_DRAIN = false;
    const bf16* gates; bf16* mixed;
    __device__ __forceinline__ void operator()(const pg8::f32x4 (&acc)[2][2][4][2], const pg8::Unit& u, int wr, int wc, int fr, int fq) const {
        const int row0 = u.pm * 256 + wr * 64 + fr, col0 = u.pn * 256 + wc * 32 + 8 * fq, br = u.br;
#pragma unroll
        for (int ai = 0; ai < 2; ++ai)
#pragma unroll
            for (int m = 0; m < 4; ++m) {
                const int row = row0 + ai * 128 + m * 16;
#pragma unroll
                for (int bj = 0; bj < 2; ++bj) {
                    const int col = col0 + bj * 128;
                    const pg8::u32x4 gv = *(const pg8::u32x4*)(gates + (size_t)row * 2048 + br * 1024 + col);
                    const pg8::f32x4 v0 = acc[ai][bj][m][0], v1 = acc[ai][bj][m][1];
                    float r[8];
                    r[0] = bflo(gv.x) * v0[0]; r[1] = bfhi(gv.x) * v0[1]; r[2] = bflo(gv.y) * v0[2]; r[3] = bfhi(gv.y) * v0[3];
                    r[4] = bflo(gv.z) * v1[0]; r[5] = bfhi(gv.z) * v1[1]; r[6] = bflo(gv.w) * v1[2]; r[7] = bfhi(gv.w) * v1[3];
                    bf16* mp = mixed + (size_t)row * 1024 + col;
                    if (br) { const pg8::u32x4 t = *(const pg8::u32x4*)mp;
                        r[0] += bflo(t.x); r[1] += bfhi(t.x); r[2] += bflo(t.y); r[3] += bfhi(t.y); r[4] += bflo(t.z); r[5] += bfhi(t.z); r[6] += bflo(t.w); r[7] += bfhi(t.w); }
                    pg8::u32x4 w; w.x = pk2(r[0], r[1]); w.y = pk2(r[2], r[3]); w.z = pk2(r[4], r[5]); w.w = pk2(r[6], r[7]);
                    *(pg8::u32x4*)mp = w;
                }
            }
    }
};
struct EpiResid {
    static constexpr bool PERM = false, AFTER_DRAIN = false;
    const float* xin; float* xout; const float* gate;
    float gs;
    __device__ __forceinline__ void operator()(const pg8::f32x4 (&acc)[2][2][4][2], const pg8::Unit& u, int wr, int wc, int fr, int fq) const {
        const int b = (u.pm * 256) / SEQ; const float* gv = gate + (size_t)b * NMOD;
        const int row0 = u.pm * 256 + wr * 64 + fr, col0 = u.pn * 256 + wc * 32 + 4 * fq;
#pragma unroll
        for (int bj = 0; bj < 2; ++bj)
#pragma unroll
            for (int n = 0; n < 2; ++n) {
                const int col = col0 + bj * 128 + n * 16;
                const pg8::f32x4 g = *(const pg8::f32x4*)(gv + col) * gs;
#pragma unroll
                for (int ai = 0; ai < 2; ++ai)
#pragma unroll
                    for (int m = 0; m < 4; ++m) {
                        const size_t off = (size_t)(row0 + ai * 128 + m * 16) * DM + col;
                        const pg8::f32x4 xi = *(const pg8::f32x4*)(xin + off);
                        *(pg8::f32x4*)(xout + off) = xi + g * acc[ai][bj][m][n];
                    }
            }
    }
};
struct BranchOrder {
    pg8::StaticOrder S;
    __device__ __forceinline__ bool next(int i, pg8::Unit& u) const { if (!S.next(i >> 1, u)) return false; u.br = i & 1; return true; }
    __device__ __forceinline__ void a_ready(const pg8::Unit&) const {}
    __device__ __forceinline__ void done(const pg8::Unit&) const {}
};

__device__ __forceinline__ void transpose_item(const float* W, int K, int N, bf16* WT, int row_off, bool perm, LAS float* scr, int item, int lane) {
    const int nblk = N / 32, kb = item / nblk, nb = item % nblk, k0 = 64 * kb, n0 = 32 * nb;
#pragma unroll 8
    for (int i = 0; i < 32; ++i) { const int kk = 2 * i + (lane >> 5); scr[kk * 33 + (lane & 31)] = W[(size_t)(k0 + kk) * N + n0 + (lane & 31)]; }
    asm volatile("s_waitcnt lgkmcnt(0)" ::: "memory");
    const int d0 = perm ? ((n0 & ~255) + 128 * ((n0 >> 5) & 1) + 32 * ((n0 >> 6) & 3)) : n0;
    const int c = lane & 7;
#pragma unroll
    for (int j = 0; j < 4; ++j) { const int n = (lane >> 3) + 8 * j; const LAS float* s = scr + (8 * c) * 33 + n;
        v4u o; o.x = pk2(s[0 * 33], s[1 * 33]); o.y = pk2(s[2 * 33], s[3 * 33]); o.z = pk2(s[4 * 33], s[5 * 33]); o.w = pk2(s[6 * 33], s[7 * 33]);
        *(v4u*)(WT + (size_t)(row_off + d0 + n) * K + k0 + 8 * c) = o; }
    asm volatile("s_waitcnt lgkmcnt(0)" ::: "memory");
}
__device__ __forceinline__ void rms_row_to_bf16(const float* xrow, bf16* orow, const float* gn, const float* sc, const float* sh, int lane) {
    const f32x4* xr = (const f32x4*)xrow + lane;
    f32x4 v[4]; float s = 0.f;
#pragma unroll
    for (int j = 0; j < 4; ++j) { v[j] = xr[64 * j]; s += (v[j].x * v[j].x + v[j].y * v[j].y) + (v[j].z * v[j].z + v[j].w * v[j].w); }
    const float rstd = 1.0f / sqrtf(wave_sum_l(s, lane) * (1.f / DM) + 1e-6f);
    unsigned long long* o8 = (unsigned long long*)orow + lane;
#pragma unroll
    for (int j = 0; j < 4; ++j) {
        const f32x4 g = ((const f32x4*)gn)[lane + 64 * j], c = ((const f32x4*)sc)[lane + 64 * j], h = ((const f32x4*)sh)[lane + 64 * j];
        const f32x4 y = (v[j] * rstd) * g * (c + 1.0f) + h;
        o8[64 * j] = (unsigned long long)pk2(y.x, y.y) | ((unsigned long long)pk2(y.z, y.w) << 32);
    }
}
__device__ __forceinline__ void sincos_acc(float ang, float& sn, float& cs) {
    const double a = (double)ang;
    const double kf = __builtin_rint(a * 0.6366197723675814);
    double r = __builtin_fma(-kf, 1.5707963267948966, a); r = __builtin_fma(-kf, 6.123233995736766e-17, r);
    const double r2 = r * r;
    double sp = -1.0 / 6227020800.0 * 0.0 + 1.0 / 6227020800.0;
    sp = sp * r2 - 1.0 / 39916800.0; sp = sp * r2 + 1.0 / 362880.0; sp = sp * r2 - 1.0 / 5040.0; sp = sp * r2 + 1.0 / 120.0; sp = sp * r2 - 1.0 / 6.0; sp = sp * r2 + 1.0;
    const double s = sp * r;
    double cp = 1.0 / 479001600.0;
    cp = cp * r2 - 1.0 / 3628800.0; cp = cp * r2 + 1.0 / 40320.0; cp = cp * r2 - 1.0 / 720.0; cp = cp * r2 + 1.0 / 24.0; cp = cp * r2 - 0.5; cp = cp * r2 + 1.0;
    const int q = ((int)kf) & 3;
    const double ss = (q == 0) ? s : (q == 1) ? cp : (q == 2) ? -s : -cp;
    const double cc = (q == 0) ? cp : (q == 1) ? -s : (q == 2) ? -cp : s;
    sn = (float)ss; cs = (float)cc;
}

constexpr int SWA_KP = 144, SWA_VP = 528;
__device__ __forceinline__ void swa_unit(int b, int kvh, int qblk, bf16* Qs, const bf16* Ks, const bf16* Vs, const float* sinks, LAS unsigned char* lds, bf16* dummy = nullptr) {
    const int tid = opaque_tid(), lane = tid & 63, r32 = lane & 31, hi = lane >> 5; const int wid = __builtin_amdgcn_readfirstlane(tid >> 6);
    const long rowbase = (long)b * SEQ; const int q0 = qblk * 128, kv0 = q0 - 128;
    LAS unsigned char* Kl = lds; LAS unsigned char* Vt = lds + 256 * SWA_KP;
#pragma unroll
    for (int i = 0; i < 4; ++i) {
        const int ch = tid + 512 * i, row = ch >> 3, c8 = ch & 7, kabs = kv0 + row;
        v4u kv = {0u, 0u, 0u, 0u}, vv = {0u, 0u, 0u, 0u};
        if (kabs >= 0) { kv = *(const v4u*)(Ks + (size_t)(rowbase + kabs) * 256 + kvh * 64 + c8 * 8); vv = *(const v4u*)(Vs + (size_t)(rowbase + kabs) * 256 + kvh * 64 + c8 * 8); }
        *(LAS v4u*)(Kl + row * SWA_KP + c8 * 16) = kv;
#pragma unroll
        for (int j = 0; j < 4; ++j) { const unsigned w = vv[j];
            *(LAS unsigned short*)(Vt + (c8 * 8 + 2 * j) * SWA_VP + row * 2) = (unsigned short)(w & 0xffffu);
            *(LAS unsigned short*)(Vt + (c8 * 8 + 2 * j + 1) * SWA_VP + row * 2) = (unsigned short)(w >> 16); }
    }
    __syncthreads();
#pragma unroll 1
    for (int tt = 0; tt < 2; ++tt) {
        const int task = wid * 2 + tt, g = task >> 2, t = task & 3, qh = kvh * 4 + g;
        bf16* qp = Qs + (size_t)(rowbase + q0 + 32 * t + r32) * 1024 + qh * 64 + hi * 8;
        bf16x8 qr[4];
#pragma unroll
        for (int d0 = 0; d0 < 4; ++d0) qr[d0] = *(const bf16x8*)(qp + d0 * 16);
        const float sink2 = sinks[qh] * LOG2E;
        f32x16 p[5];
#pragma unroll
        for (int jt = 0; jt < 5; ++jt) {
            const LAS unsigned char* kb = Kl + ((t + jt) * 32 + r32) * SWA_KP + hi * 16;
            f32x16 a = {};
#pragma unroll
            for (int d0 = 0; d0 < 4; ++d0) { const bf16x8 kf = *(const LAS bf16x8*)(kb + d0 * 32); a = __builtin_amdgcn_mfma_f32_32x32x16_bf16(kf, qr[d0], a, 0, 0, 0); }
            p[jt] = a;
        }
        float mx = sink2;
#pragma unroll
        for (int jt = 0; jt < 5; ++jt)
#pragma unroll
            for (int i = 0; i < 16; ++i) {
                const int cr = (i & 3) + 8 * (i >> 2) + 4 * hi, dlt = 128 + r32 - 32 * jt - cr, kabs = kv0 + (t + jt) * 32 + cr;
                const bool vis = (dlt >= 0) && (dlt < 128) && (kabs >= 0);
                p[jt][i] = vis ? p[jt][i] : -INFINITY; mx = fmaxf(mx, p[jt][i]);
            }
        mx = fmaxf(mx, shflx(mx, 32, lane));
        float sum = 0.f;
#pragma unroll
        for (int jt = 0; jt < 5; ++jt)
#pragma unroll
            for (int i = 0; i < 16; ++i) { const float e = __builtin_amdgcn_exp2f(p[jt][i] - mx); p[jt][i] = e; sum += e; }
        sum += shflx(sum, 32, lane);
        const float linv = 1.0f / (sum + __builtin_amdgcn_exp2f(sink2 - mx));
        f32x16 o[2]; o[0] = f32x16{}; o[1] = f32x16{};
#pragma unroll
        for (int jt = 0; jt < 5; ++jt)
#pragma unroll
            for (int s = 0; s < 2; ++s) {
                v4u pw; pw.x = pk2(p[jt][8 * s], p[jt][8 * s + 1]); pw.y = pk2(p[jt][8 * s + 2], p[jt][8 * s + 3]); pw.z = pk2(p[jt][8 * s + 4], p[jt][8 * s + 5]); pw.w = pk2(p[jt][8 * s + 6], p[jt][8 * s + 7]);
                const bf16x8 pa = __builtin_bit_cast(bf16x8, pw);
#pragma unroll
                for (int d0 = 0; d0 < 2; ++d0) {
                    const LAS unsigned char* vp = Vt + (d0 * 32 + r32) * SWA_VP + ((t + jt) * 32 + 16 * s + 4 * hi) * 2;
                    const s16x4 lo = *(const LAS s16x4*)vp, h4 = *(const LAS s16x4*)(vp + 16);
                    const bf16x8 vb = __builtin_shufflevector(lo, h4, 0, 1, 2, 3, 4, 5, 6, 7);
                    o[d0] = __builtin_amdgcn_mfma_f32_32x32x16_bf16(pa, vb, o[d0], 0, 0, 0);
                }
            }
        bf16* op = dummy ? dummy + (size_t)((q0 + 32 * t) & 4095) * 1024 + qh * 64 + r32 : Qs + (size_t)(rowbase + q0 + 32 * t) * 1024 + qh * 64 + r32;
#pragma unroll
        for (int i = 0; i < 16; ++i) {
            const int cr = (i & 3) + 8 * (i >> 2) + 4 * hi; const float li = __uint_as_float(__builtin_amdgcn_ds_bpermute(cr << 2, __float_as_uint(linv)));
            op[(size_t)cr * 1024] = (bf16)f2bf(o[0][i] * li); op[(size_t)cr * 1024 + 32] = (bf16)f2bf(o[1][i] * li);
        }
    }
    __syncthreads();
}

#define XB_TMO      128
#define XB_XCNT(j)  (256  + 64 * (j))
#define XB_XSUB(j)  (1280 + 64 * (j))
#define XB_XGEN(j)  (2304 + 64 * (j))
#define XB_TOP      3328
#define XB_TOPGEN   3392
#define XCD_BAR_WORDS 3456
#define XB_SPIN_CAP (1u << 18)

__device__ __forceinline__ unsigned xb_ld(unsigned* p)              { return __hip_atomic_load(p, __ATOMIC_RELAXED, __HIP_MEMORY_SCOPE_AGENT); }
__device__ __forceinline__ unsigned xb_add(unsigned* p, unsigned v) { return __hip_atomic_fetch_add(p, v, __ATOMIC_RELAXED, __HIP_MEMORY_SCOPE_AGENT); }
__device__ __forceinline__ unsigned xb_xcc_id() { return (unsigned)__builtin_amdgcn_s_getreg((3 << 11) | 20) & 0xFu; }
#define XB_SPIN(cond, bar) do { unsigned _sp = 0; while (cond) { __builtin_amdgcn_s_sleep(1); \
    if ((++_sp & 255u) == 0u) { if (xb_ld(&(bar)[XB_TMO])) break; if (_sp > XB_SPIN_CAP) { atomicAdd(&(bar)[XB_TMO], 1u); break; } } } } while (0)

struct XcdBarrier {
    unsigned* bar; unsigned x;
    volatile LAS unsigned* st;
};

__device__ __forceinline__ XcdBarrier xcd_barrier_post(unsigned* bar, volatile LAS unsigned* st) {
    XcdBarrier b; b.bar = bar; b.x = xb_xcc_id(); b.st = st;
    if (threadIdx.x == 0) (void)xb_add(&bar[XB_XCNT(b.x)], 1u);
    return b;
}
__device__ __forceinline__ void xcd_barrier_complete(unsigned* bar, unsigned x, unsigned& nloc, unsigned& nx) {
    const unsigned G = gridDim.x * gridDim.y * gridDim.z;
    unsigned sum, cnt, mine, sp = 0u;
    for (;;) {
        sum = 0u; cnt = 0u; mine = 0u;
#pragma unroll
        for (unsigned j = 0; j < 16; ++j) { const unsigned c = xb_ld(&bar[XB_XCNT(j)]); sum += c; cnt += (c > 0u) ? 1u : 0u; mine = (j == x) ? c : mine; }
        if (sum == G) break;
        __builtin_amdgcn_s_sleep(1);
        if ((++sp & 255u) == 0u) { if (xb_ld(&bar[XB_TMO])) break; if (sp > XB_SPIN_CAP) { atomicAdd(&bar[XB_TMO], 1u); break; } }
    }
    nloc = mine > 0u ? mine : 1u; nx = cnt > 0u ? cnt : 1u;
}

__device__ __forceinline__ void xcd_barrier(const XcdBarrier& b) {
    asm volatile("s_waitcnt vmcnt(0)" ::: "memory");
    __syncthreads();
    if (threadIdx.x == 0) {
        unsigned* bar = b.bar;
        __builtin_amdgcn_s_waitcnt(0);
        unsigned nloc = b.st[0], nx = b.st[1];
        if (nloc == 0u) { xcd_barrier_complete(bar, b.x, nloc, nx); b.st[0] = nloc; b.st[1] = nx; }
        const unsigned old = xb_add(&bar[XB_XSUB(b.x)], 1u);
        const unsigned gen = old / nloc;
        if (old + 1u == (gen + 1u) * nloc) {
            __builtin_amdgcn_fence(__ATOMIC_RELEASE, "agent");
            asm volatile("s_waitcnt vmcnt(0)" ::: "memory");
            const unsigned og = xb_add(&bar[XB_TOP], 1u);
            const unsigned tg = og / nx;
            if (og + 1u == (tg + 1u) * nx) xb_add(&bar[XB_TOPGEN], 1u);
            else XB_SPIN(xb_ld(&bar[XB_TOPGEN]) == tg, bar);
            __builtin_amdgcn_fence(__ATOMIC_ACQUIRE, "agent");
            xb_add(&bar[XB_XGEN(b.x)], 1u);
            asm volatile("s_waitcnt vmcnt(0)" ::: "memory");
        } else {
            XB_SPIN(xb_ld(&bar[XB_XGEN(b.x)]) == gen, bar);
            __builtin_amdgcn_fence(__ATOMIC_ACQUIRE, "agent");
            asm volatile("s_waitcnt vmcnt(0)" ::: "memory");
        }
    }
    __syncthreads();
}

#ifdef PROBE_SYNC2
#define GSYNC() do { xcd_barrier(xbar); xcd_barrier(xbar); } while (0)
#else
#define GSYNC() xcd_barrier(xbar)
#endif
#define PH_TID() const int tid = opaque_tid(), lane = tid & 63, wave = __builtin_amdgcn_readfirstlane(tid >> 6); (void)lane; (void)wave; \
    const int gw = vcu * 8 + wave, NGW = G * 8; (void)gw; (void)NGW; unsigned char* ws = ld_ws(); (void)ws
__global__ void __launch_bounds__(512, 2) fwd_megakernel(Params p) {
    extern __shared__ __attribute__((aligned(16))) unsigned char lds_raw[];
    cg::grid_group grid = cg::this_grid();
    LAS unsigned char* lds = (LAS unsigned char*)lds_raw;
    const int G = gridDim.x, bx = blockIdx.x;
    const int vcu = (G % 8 == 0) ? (bx % 8) * (G / 8) + bx / 8 : bx;
    volatile LAS unsigned* xst = (volatile LAS unsigned*)(lds + LDS_BYTES - 64);
    if (threadIdx.x < 2) xst[threadIdx.x] = 0u;
    __syncthreads();
    const XcdBarrier xbar = xcd_barrier_post((unsigned*)(p.ws + WS_BAR), xst);

#ifndef SKIP_P0
#ifdef PROBE_P02
    for (int rep_ = 0; rep_ < 2; ++rep_)
#endif
    {
        const int tid = threadIdx.x, lane = tid & 63, wave = __builtin_amdgcn_readfirstlane(tid >> 6); unsigned char* ws = p.ws;
        const float* c_in = p.in[1]; const int* pos = (const int*)p.in[2]; const float* w_ada = p.in[3]; const float* b_ada = p.in[4];
        float* mod = (float*)(ws + WS_MOD); float* rope = (float*)(ws + WS_ROPE);
#ifndef SKIP_ROPE
        for (int e0 = bx * 512; e0 < M * 32; e0 += G * 512) {
            const int e = e0 + tid; const int row = e >> 5, i = e & 31;
            const float inv_freq = (float)exp2(-(double)(2 * i) * (13.287712379549449 / 64.0));
            const float ang = (float)pos[row] * inv_freq;
            float sn, cs; sincos_acc(ang, sn, cs);
            rope[(size_t)row * 64 + i] = cs; rope[(size_t)row * 64 + 32 + i] = sn;
        }
#endif
#ifndef SKIP_MOD
        {
            LAS float* cact = (LAS float*)lds;
            LAS float* red = (LAS float*)(lds + 16384);
            for (int e = tid; e < NB * DM; e += 512) cact[e] = fast_silu(c_in[e]);
            __syncthreads();
            for (int unit = bx; unit < DEPTH * 96; unit += G) {
                const int l = unit / 96, col = (unit % 96) * 64 + lane;
                const float* Wp = w_ada + (size_t)l * DM * NMOD + (size_t)(wave * 128) * NMOD + col;
                float a0 = 0.f, a1 = 0.f, a2 = 0.f, a3 = 0.f;
#pragma unroll 8
                for (int kk = 0; kk < 128; ++kk) { const float w = Wp[(size_t)kk * NMOD]; const int k = wave * 128 + kk;
                    a0 += cact[k] * w; a1 += cact[1024 + k] * w; a2 += cact[2048 + k] * w; a3 += cact[3072 + k] * w; }
                red[(wave * 4 + 0) * 64 + lane] = a0; red[(wave * 4 + 1) * 64 + lane] = a1; red[(wave * 4 + 2) * 64 + lane] = a2; red[(wave * 4 + 3) * 64 + lane] = a3;
                __syncthreads();
                if (wave < 4) { float s = b_ada[(size_t)l * NMOD + col];
#pragma unroll
                    for (int w = 0; w < 8; ++w) s += red[(w * 4 + wave) * 64 + lane];
                    mod[(size_t)(l * NB + wave) * NMOD + col] = s; }
                __syncthreads();
            }
        }
#endif
    }
#endif
    grid.sync();

#pragma unroll 1
    for (int l = 0; l < DEPTH; ++l) {
#ifndef SKIP_P1
#ifdef PROBE_THIN2
        for (int rep_ = 0; rep_ < 2; ++rep_)
#endif
        {
            PH_TID();
            LAS float* scr = (LAS float*)(lds + wave * 16384);
            const float* xcur = (l == 0) ? inptr(p, 0) : (const float*)ld_out();
            const float* modl = (const float*)(ws + WS_MOD) + (size_t)l * NB * NMOD;
            const float* w_in = inptr(p, 6); const float* w_ba = inptr(p, 10); const float* w_bb = inptr(p, 11); const float* w_out = inptr(p, 12); const float* attn_norm = inptr(p, 5);
            constexpr int I_IN = 16 * (INW / 32), I_SQ = 16 * 32;
            for (int it = gw; it < I_IN + 3 * I_SQ; it += NGW) {
                int r = it;
                if (r < I_IN) { transpose_item(w_in + (size_t)l * DM * INW, DM, INW, (bf16*)(ws + WS_WIN), 0, true, scr, r, lane); continue; } r -= I_IN;
                if (r < I_SQ) { transpose_item(w_ba + (size_t)l * DM * DM, DM, DM, (bf16*)(ws + WS_WA), 0, false, scr, r, lane); continue; } r -= I_SQ;
                if (r < I_SQ) { transpose_item(w_bb + (size_t)l * DM * DM, DM, DM, (bf16*)(ws + WS_WB), 0, false, scr, r, lane); continue; } r -= I_SQ;
                transpose_item(w_out + (size_t)l * DM * DM, DM, DM, (bf16*)(ws + WS_WO), 0, false, scr, r, lane);
            }
            bf16* H = (bf16*)(ws + WS_H);
            for (int m = gw; m < M; m += NGW) { const float* mb = modl + (size_t)(m / SEQ) * NMOD;
                rms_row_to_bf16(xcur + (size_t)m * DM, H + (size_t)m * DM, attn_norm + l * DM, mb + 1024, mb, lane); }
        }
#endif
        GSYNC();
#ifndef SKIP_P2
#ifdef PROBE_GEMM2
        for (int rep_ = 0; rep_ < 2; ++rep_)
#endif
        {
            unsigned char* ws = ld_ws();
            pg8::Gemm g{(const bf16*)(ws + WS_H), (const bf16*)(ws + WS_WIN), DM, DM, DM, 0, 0}; pg8::StaticOrder S; S.init(M, INW, G, bx);
            EpiIn E{ws, (const float*)(ws + WS_ROPE)};
            pg8::gemm_phase<EpiIn, pg8::StaticOrder, PG8_ALIGN, PG8_SP2>(lds, g, S, E);
        }
#endif
        GSYNC();
#ifndef SKIP_P3
        {
#ifndef SKIP_ATTN
            float lam;
            { const int ln = opaque_tid() & 63; const float* lq = inptr(p, 7) + l * 256;
              const float s1 = wave_sum_l(lq[ln] * lq[64 + ln], ln), s2 = wave_sum_l(lq[128 + ln] * lq[192 + ln], ln);
              lam = __uint_as_float(__builtin_amdgcn_readfirstlane(__float_as_uint(expf(s1) - expf(s2) + lambda_init_of(l)))); }
#ifdef PROBE_ATTN2
            for (int rep_ = 0; rep_ < 2; ++rep_)
#endif
#ifdef ATT_V2
            const float* gsub = inptr(p, 8) + l * 128; const float onem = 1.0f - lambda_init_of(l);
            for (int it = vcu; it < 512; it += G) {
                const int bh = it >> 4, pr = it & 15, b = bh >> 3, h = bh & 7;
#pragma unroll 1
                for (int k = 0; k < 2; ++k) {
                    const int qb = k ? 31 - pr : pr;
#pragma unroll 1
                    for (int c = 0; c < 2; ++c)
                        attn_body::attn_unit<8>(b, 2 * h + c, h, qb, ld_ws(), (char*)lds_raw, c, lam, gsub, onem);
                }
            }
#else
            for (int it = vcu; it < 1024; it += G) {
                const int combo = it >> 4, pr = it & 15, b = combo >> 4, h = (combo >> 1) & 7, vh = combo & 1;
#pragma unroll 1
                for (int k = 0; k < 2; ++k) {
                    const int qb = k ? 31 - pr : pr;
#pragma unroll 1
                    for (int c = 0; c < 2; ++c)
                        attn_body::attn_unit<8>(b, 2 * h + c, 2 * h + vh, qb, ld_ws(), (char*)lds_raw, c, lam);
                }
            }
#endif
#endif
#ifndef SKIP_SWA
            { const float* sinks = inptr(p, 9) + l * 16;
#ifdef PROBE_SWA2
              for (int u = vcu; u < 1024; u += G) { unsigned char* ws = ld_ws(); swa_unit(u >> 8, (u >> 6) & 3, u & 63, (bf16*)(ws + WS_QS), (const bf16*)(ws + WS_KS), (const bf16*)(ws + WS_VS), sinks, lds, (bf16*)(ws + WS_WIN)); }
#endif
              for (int u = vcu; u < 1024; u += G) { unsigned char* ws = ld_ws(); swa_unit(u >> 8, (u >> 6) & 3, u & 63, (bf16*)(ws + WS_QS), (const bf16*)(ws + WS_KS), (const bf16*)(ws + WS_VS), sinks, lds); } }
#endif
        }
#endif
        GSYNC();
#ifndef ATT_V2
#ifndef SKIP_P4
#ifdef PROBE_THIN2
        for (int rep_ = 0; rep_ < 2; ++rep_)
#endif
        {
            PH_TID();
            const float* ssq = (const float*)(ws + WS_SSQ); const bf16* H = (const bf16*)(ws + WS_H); bf16* QA = (bf16*)(ws + WS_QA);
            const float* subln = inptr(p, 8); const float lam_init = lambda_init_of(l);
            for (int m = gw; m < M; m += NGW) {
                const int head = lane >> 3, e0 = (lane & 7) * 16;
                const float ss = ssq[(size_t)m * 16 + 2 * head] + ssq[(size_t)m * 16 + 2 * head + 1];
                const float rs = (1.0f / sqrtf(ss * (1.f / 128.f) + 1e-5f)) * (1.0f - lam_init);
                const v4u d0 = *(const v4u*)(H + (size_t)m * DM + lane * 16), d1 = *(const v4u*)(H + (size_t)m * DM + lane * 16 + 8);
                const float* gp = subln + l * 128 + e0;
                v4u o0, o1;
                o0.x = pk2(bflo(d0.x) * rs * gp[0], bfhi(d0.x) * rs * gp[1]); o0.y = pk2(bflo(d0.y) * rs * gp[2], bfhi(d0.y) * rs * gp[3]);
                o0.z = pk2(bflo(d0.z) * rs * gp[4], bfhi(d0.z) * rs * gp[5]); o0.w = pk2(bflo(d0.w) * rs * gp[6], bfhi(d0.w) * rs * gp[7]);
                o1.x = pk2(bflo(d1.x) * rs * gp[8], bfhi(d1.x) * rs * gp[9]); o1.y = pk2(bflo(d1.y) * rs * gp[10], bfhi(d1.y) * rs * gp[11]);
                o1.z = pk2(bflo(d1.z) * rs * gp[12], bfhi(d1.z) * rs * gp[13]); o1.w = pk2(bflo(d1.w) * rs * gp[14], bfhi(d1.w) * rs * gp[15]);
                *(v4u*)(QA + (size_t)m * DM + lane * 16) = o0; *(v4u*)(QA + (size_t)m * DM + lane * 16 + 8) = o1;
            }
        }
#endif
        GSYNC();
#endif
#ifndef SKIP_P5
#ifdef PROBE_GEMM2
        for (int rep_ = 0; rep_ < 2; ++rep_)
#endif
        {
            unsigned char* ws = ld_ws();
            pg8::Gemm g{(const bf16*)(ws + WS_QA), (const bf16*)(ws + WS_WA), DM, DM, DM, (size_t)(WS_QS - WS_QA), (size_t)(WS_WB - WS_WA)}; BranchOrder S; S.S.init(M, DM, G, bx);
            EpiBranch E{(const bf16*)(ws + WS_GATES), (bf16*)(ws + WS_MIXED)};
            pg8::gemm_phase<EpiBranch, BranchOrder, PG8_ALIGN, PG8_SP2>(lds, g, S, E);
        }
#endif
        GSYNC();
#ifndef SKIP_P6
#ifdef PROBE_RES2
        for (int repp6_ = 0; repp6_ < 2; ++repp6_)
#else
        const int repp6_ = 1;
#endif
        {
            unsigned char* ws = ld_ws();
            float* out = ld_out();
            const float* xcur = (l == 0) ? inptr(p, 0) : (const float*)out;
            pg8::Gemm g{(const bf16*)(ws + WS_MIXED), (const bf16*)(ws + WS_WO), DM, DM, DM, 0, 0}; pg8::StaticOrder S; S.init(M, DM, G, bx);
            EpiResid E{repp6_ ? xcur : (const float*)out, out, (const float*)(ws + WS_MOD) + (size_t)l * NB * NMOD + 2048, repp6_ ? 1.f : 0.f};
            pg8::gemm_phase<EpiResid, pg8::StaticOrder, PG8_ALIGN, PG8_SP2>(lds, g, S, E);
        }
#endif
        GSYNC();
#ifndef SKIP_P7
#ifdef PROBE_THIN2
        for (int rep_ = 0; rep_ < 2; ++rep_)
#endif
        {
            PH_TID();
            LAS float* scr = (LAS float*)(lds + wave * 16384);
            const float* out = (const float*)ld_out();
            const float* modl = (const float*)(ws + WS_MOD) + (size_t)l * NB * NMOD;
            const float* w_gate = inptr(p, 14); const float* w_up = inptr(p, 15); const float* w_down = inptr(p, 18); const float* ffn_norm = inptr(p, 13);
            constexpr int I_G = 16 * (DFF / 32), I_D = (DFF / 64) * 32;
            for (int it = gw; it < 2 * I_G + I_D; it += NGW) {
                int r = it;
                if (r < I_G) { transpose_item(w_gate + (size_t)l * DM * DFF, DM, DFF, (bf16*)(ws + WS_WGU), 0, false, scr, r, lane); continue; } r -= I_G;
                if (r < I_G) { transpose_item(w_up + (size_t)l * DM * DFF, DM, DFF, (bf16*)(ws + WS_WGU), DFF, false, scr, r, lane); continue; } r -= I_G;
                transpose_item(w_down + (size_t)l * DFF * DM, DFF, DM, (bf16*)(ws + WS_WD), 0, false, scr, r, lane);
            }
            bf16* H = (bf16*)(ws + WS_H);
            for (int m = gw; m < M; m += NGW) { const float* mb = modl + (size_t)(m / SEQ) * NMOD;
                rms_row_to_bf16(out + (size_t)m * DM, H + (size_t)m * DM, ffn_norm + l * DM, mb + 4096, mb + 3072, lane); }
        }
#endif
        GSYNC();
#ifndef SKIP_P8
#ifdef PROBE_GEMM2
        for (int rep_ = 0; rep_ < 2; ++rep_)
#endif
        {
            unsigned char* ws = ld_ws();
            pg8::Gemm g{(const bf16*)(ws + WS_H), (const bf16*)(ws + WS_WGU), DM, DM, DM, 0, 0}; pg8::StaticOrder S; S.init(M, 2 * DFF, G, bx);
            pg8::EpiBf16<0> E{(bf16*)(ws + WS_GU), 2 * DFF, nullptr, 0, 0, 1.f};
            pg8::gemm_phase<pg8::EpiBf16<0>, pg8::StaticOrder, PG8_ALIGN, PG8_SP2>(lds, g, S, E);
        }
#endif
        GSYNC();
#ifndef SKIP_P9
#ifdef PROBE_THIN2
        for (int repp9_ = 0; repp9_ < 2; ++repp9_)
#else
        const int repp9_ = 1;
#endif
        {
            PH_TID();
            bf16* GU = (bf16*)(ws + WS_GU); const float* conv_w = inptr(p, 16); const float* conv_b = inptr(p, 17);
            for (int item = bx; item < M / 64; item += G) {
                if (tid < DFF / 8) {
                    const int col = tid * 8, r0 = item * 64;
                    float cw0[8], cw1[8], cw2[8], cb[8], gm2[8], gm1[8];
#pragma unroll
                    for (int j = 0; j < 8; ++j) { cw0[j] = conv_w[(size_t)(l * 3 + 0) * DFF + col + j]; cw1[j] = conv_w[(size_t)(l * 3 + 1) * DFF + col + j]; cw2[j] = conv_w[(size_t)(l * 3 + 2) * DFF + col + j];
                        cb[j] = conv_b[(size_t)l * DFF + col + j]; gm2[j] = 0.f; gm1[j] = 0.f; }
                    if ((r0 % SEQ) != 0) {
                        const v4u a = *(const v4u*)(GU + (size_t)(r0 - 2) * (2 * DFF) + col), bq = *(const v4u*)(GU + (size_t)(r0 - 1) * (2 * DFF) + col);
                        gm2[0] = bflo(a.x); gm2[1] = bfhi(a.x); gm2[2] = bflo(a.y); gm2[3] = bfhi(a.y); gm2[4] = bflo(a.z); gm2[5] = bfhi(a.z); gm2[6] = bflo(a.w); gm2[7] = bfhi(a.w);
                        gm1[0] = bflo(bq.x); gm1[1] = bfhi(bq.x); gm1[2] = bflo(bq.y); gm1[3] = bfhi(bq.y); gm1[4] = bflo(bq.z); gm1[5] = bfhi(bq.z); gm1[6] = bflo(bq.w); gm1[7] = bfhi(bq.w);
                    }
#pragma unroll 4
                    for (int r = 0; r < 64; ++r) {
                        bf16* gp = GU + (size_t)(r0 + r) * (2 * DFF) + col;
                        const v4u gv = *(const v4u*)gp, uv = *(const v4u*)(gp + DFF);
                        float gq[8], uq[8], a[8];
                        gq[0] = bflo(gv.x); gq[1] = bfhi(gv.x); gq[2] = bflo(gv.y); gq[3] = bfhi(gv.y); gq[4] = bflo(gv.z); gq[5] = bfhi(gv.z); gq[6] = bflo(gv.w); gq[7] = bfhi(gv.w);
                        uq[0] = bflo(uv.x); uq[1] = bfhi(uv.x); uq[2] = bflo(uv.y); uq[3] = bfhi(uv.y); uq[4] = bflo(uv.z); uq[5] = bfhi(uv.z); uq[6] = bflo(uv.w); uq[7] = bfhi(uv.w);
#pragma unroll
                        for (int j = 0; j < 8; ++j) { const float gc = cb[j] + cw0[j] * gm2[j] + cw1[j] * gm1[j] + cw2[j] * gq[j]; a[j] = fast_silu(gc) * uq[j]; gm2[j] = gm1[j]; gm1[j] = gq[j]; }
                        v4u o; o.x = pk2(a[0], a[1]); o.y = pk2(a[2], a[3]); o.z = pk2(a[4], a[5]); o.w = pk2(a[6], a[7]);
                        *(v4u*)(gp + DFF) = repp9_ ? o : uv;
                    }
                }
            }
        }
#endif
        GSYNC();
#ifndef SKIP_P10
#ifdef PROBE_RES2
        for (int repp10_ = 0; repp10_ < 2; ++repp10_)
#else
        const int repp10_ = 1;
#endif
        {
            unsigned char* ws = ld_ws();
            float* out = ld_out();
            pg8::Gemm g{(const bf16*)(ws + WS_GU) + DFF, (const bf16*)(ws + WS_WD), 2 * DFF, DFF, DFF, 0, 0}; pg8::StaticOrder S; S.init(M, DM, G, bx);
            EpiResid E{out, out, (const float*)(ws + WS_MOD) + (size_t)l * NB * NMOD + 5120, repp10_ ? 1.f : 0.f};
            pg8::gemm_phase<EpiResid, pg8::StaticOrder, PG8_ALIGN, PG8_SP2>(lds, g, S, E);
        }
#endif
        GSYNC();
    }
    {
        PH_TID();
        float* out = ld_out(); const float* final_norm = inptr(p, 19);
        for (int m = gw; m < M; m += NGW) {
            f32x4* xr = (f32x4*)(out + (size_t)m * DM) + lane;
            f32x4 v[4]; float s = 0.f;
#pragma unroll
            for (int j = 0; j < 4; ++j) { v[j] = xr[64 * j]; s += (v[j].x * v[j].x + v[j].y * v[j].y) + (v[j].z * v[j].z + v[j].w * v[j].w); }
            const float rstd = 1.0f / sqrtf(wave_sum_l(s, lane) * (1.f / DM) + 1e-6f);
#pragma unroll
            for (int j = 0; j < 4; ++j) xr[64 * j] = (v[j] * rstd) * ((const f32x4*)final_norm)[lane + 64 * j];
        }
    }
}

extern "C" void kernel_launch(void* const* d_in, const int* in_sizes, int n_in, void* d_out, int out_size, void* d_ws, size_t ws_size, hipStream_t stream) {
    static int grid_blocks = 0;
    if (grid_blocks == 0) {
        if (n_in != 20 || ws_size < WS_END || out_size != M * DM) { fprintf(stderr, "kernel_launch: unexpected problem (n_in %d, ws %zu, out %d)\n", n_in, ws_size, out_size); grid_blocks = -1; return; }
        int dev = 0, cus = 0, per_cu = 0;
        hipGetDevice(&dev);
        hipDeviceGetAttribute(&cus, hipDeviceAttributeMultiprocessorCount, dev);
        hipFuncSetAttribute((const void*)fwd_megakernel, hipFuncAttributeMaxDynamicSharedMemorySize, LDS_BYTES);
        hipOccupancyMaxActiveBlocksPerMultiprocessor(&per_cu, (const void*)fwd_megakernel, 512, LDS_BYTES);
        if (per_cu < 1) per_cu = 1;
        grid_blocks = cus * per_cu;
        (void)hipGetLastError();
    }
    if (grid_blocks < 0) return;
    if (hipMemsetAsync((char*)d_ws + WS_BAR, 0, 16384, stream) != hipSuccess) { fprintf(stderr, "memset failed\n"); return; }
    Params p{};
    for (int i = 0; i < 20; ++i) p.in[i] = (const float*)d_in[i];
    p.out = (float*)d_out; p.ws = (unsigned char*)d_ws;
    void* args[] = {&p};
    hipError_t e = hipLaunchCooperativeKernel((const void*)fwd_megakernel, dim3(grid_blocks), dim3(512), args, LDS_BYTES, stream);
    if (e != hipSuccess) fprintf(stderr, "cooperative launch failed: %s (grid %d)\n", hipGetErrorString(e), grid_blocks);
}
```

```cpp
#define ATT_V2 1
#define FUSE_GU 1
#include <hip/hip_runtime.h>
#include <cstdio>
#include <cstdint>
namespace pg8 {
#define PG8_LAS __attribute__((address_space(3)))
typedef unsigned short bf16_t;
typedef short bf16x8 __attribute__((ext_vector_type(8)));
typedef float f32x4 __attribute__((ext_vector_type(4)));
typedef unsigned u32x4 __attribute__((ext_vector_type(4)));
constexpr int BM = 256, BK = 64, HALF = 128, HTB = HALF * BK * 2  , STAGE_BYTES = 8 * HTB, NXCD = 8, WGM = 8;

__host__ __device__ __forceinline__ int lds_byte(int r, int c) { const int st = (r >> 4) * 2 + (c >> 5), rr = r & 15, cc = c & 31, ob = rr * 64 + cc * 2; return st * 1024 + (ob ^ (((ob >> 9) & 1) << 5)); }
__host__ __device__ __forceinline__ void stage_rc(int b, int& R, int& C) { const int st = b / 1024, sb = b % 1024, swz = sb ^ (((sb >> 9) & 1) << 5); R = (st >> 1) * 16 + swz / 64; C = (st & 1) * 32 + (swz % 64) / 2; }
__host__ __device__ __forceinline__ int perm32(int rho) { const int n = rho >> 4, i = rho & 15; return 8 * (i >> 2) + 4 * n + (i & 3); }

struct Unit { int pm, pn, br; };
struct Gemm { const bf16_t* A; const bf16_t* Bt; int lda, ldb, K; size_t abr, bbr; };

struct StaticOrder {
    int nM, nN, nwg, G, c;
    __host__ __device__ void init(int M, int N, int G_, int c_) { nM = M / BM; nN = N / BM; nwg = nM * nN; G = G_; c = c_; }
    __host__ __device__ bool next(int i, Unit& u) const {
        const long L = (long)i * G + c; if (L >= nwg) return false;
        int wgid = (int)L; { const int q = nwg / NXCD, r = nwg % NXCD, xcd = wgid % NXCD, off = wgid / NXCD; wgid = (xcd < r ? xcd * (q + 1) : r * (q + 1) + (xcd - r) * q) + off; }
        const int nig = WGM * nN, gid = wgid / nig, fm = gid * WGM, gsz = (nM - fm) < WGM ? (nM - fm) : WGM;
        u.pm = fm + ((wgid % nig) % gsz); u.pn = (wgid % nig) / gsz; u.br = 0; return true;
    }
    __device__ __forceinline__ void a_ready(const Unit&) const {}
    __device__ __forceinline__ void done(const Unit&) const {}
};

__device__ __forceinline__ unsigned cvt_pk_bf16(float lo, float hi) { unsigned r; asm volatile("v_cvt_pk_bf16_f32 %0, %1, %2" : "=v"(r) : "v"(lo), "v"(hi)); return r; }
typedef float f32x2 __attribute__((ext_vector_type(2)));
__device__ __forceinline__ f32x2 gelu_pk(f32x2 v) {
    const f32x2 av = __builtin_elementwise_abs(v), d = av * 0.2316418882f + 1.0f;
    f32x2 t; t.x = __builtin_amdgcn_rcpf(d.x); t.y = __builtin_amdgcn_rcpf(d.y);
    f32x2 q = t * 0.5307027145f + (-0.7265760135f); q = q * t + 0.7107068705f; q = q * t + (-0.142248368f); q = q * t + 0.127414796f; q = q * t;
    const f32x2 s = (v * v) * (-0.72134752044f);
    f32x2 e; e.x = __builtin_amdgcn_exp2f(s.x); e.y = __builtin_amdgcn_exp2f(s.y);
    const f32x2 m = v * (q * e), r = v - m;
    f32x2 o; o.x = v.x < 0.f ? m.x : r.x; o.y = v.y < 0.f ? m.y : r.y; return o;
}

template <int ACT  > struct EpiBf16 {
    static constexpr bool PERM = true, AFTER_DRAIN = false; static_assert(ACT == 0 || ACT == 1, "EpiBf16: ACT is 0 (none) or 1 (gelu_pk)");
    bf16_t* O; int ldc; const float* bias; int split_cols; size_t split_stride; float scale0;
    __device__ __forceinline__ void operator()(const f32x4 (&acc)[2][2][4][2], const Unit& u, int wr, int wc, int fr, int fq) const {
        const int row0 = u.pm * BM + wr * 64 + fr; int colt = u.pn * BM; bf16_t* base = O;
        float sc = 1.f; if (split_cols) { const int t = colt / split_cols; base += (size_t)t * split_stride; colt -= t * split_cols; if (t == 0) sc = scale0; }
        const int col0 = colt + wc * 32 + 8 * fq, bcol0 = u.pn * BM + wc * 32 + 8 * fq;
        f32x4 bv[2][2];
#pragma unroll
        for (int bj = 0; bj < 2; ++bj)
#pragma unroll
            for (int n = 0; n < 2; ++n) bv[bj][n] = bias ? *(const f32x4*)(bias + bcol0 + bj * HALF + 4 * n) : (f32x4){0.f, 0.f, 0.f, 0.f};
#pragma unroll
        for (int ai = 0; ai < 2; ++ai)
#pragma unroll
            for (int m = 0; m < 4; ++m) { bf16_t* rowp = base + (size_t)(row0 + ai * HALF + m * 16) * ldc + col0;
#pragma unroll
                for (int bj = 0; bj < 2; ++bj) { f32x4 v0 = acc[ai][bj][m][0] + bv[bj][0], v1 = acc[ai][bj][m][1] + bv[bj][1];
                    if (ACT == 1) { f32x2 a = gelu_pk((f32x2){v0[0], v0[1]}), b = gelu_pk((f32x2){v0[2], v0[3]}), c = gelu_pk((f32x2){v1[0], v1[1]}), d = gelu_pk((f32x2){v1[2], v1[3]});
                        v0 = (f32x4){a.x, a.y, b.x, b.y}; v1 = (f32x4){c.x, c.y, d.x, d.y}; }
                    v0 = v0 * sc; v1 = v1 * sc; u32x4 w; w.x = cvt_pk_bf16(v0[0], v0[1]); w.y = cvt_pk_bf16(v0[2], v0[3]); w.z = cvt_pk_bf16(v1[0], v1[1]); w.w = cvt_pk_bf16(v1[2], v1[3]);
                    *(u32x4*)(rowp + bj * HALF) = w; } }
    }
};
template <class Epi, class Sched, bool ALIGN_EPI = false, bool SP2 = false>
__device__ __forceinline__ void gemm_phase(PG8_LAS unsigned char* lds, const Gemm g, const Sched& S, const Epi& E) {
    int tid_ = threadIdx.x; asm volatile("" : "+v"(tid_)); const int tid = tid_, wid = __builtin_amdgcn_readfirstlane(tid >> 6), lane = tid & 63, wr = wid >> 2, wc = wid & 3, fr = lane & 15, fq = lane >> 4;
    const int K = g.K, nt = K / BK;
    unsigned voffA[2], voffB[2];
#pragma unroll
    for (int i = 0; i < 2; ++i) { int R, C; stage_rc(tid * 16 + i * 8192, R, C); const int Rb = Epi::PERM ? ((R & ~31) + perm32(R & 31)) : R;
        voffA[i] = (unsigned)(R * g.lda + C) * 2u; voffB[i] = (unsigned)(Rb * g.ldb + C) * 2u; }
    const size_t kstep = (size_t)(BK * 2);
    const size_t hstepA = (size_t)HALF * g.lda * 2, hstepB = (size_t)HALF * g.ldb * 2;
    const size_t tstepA = 2 * hstepA, tstepB = 2 * hstepB;
    const unsigned ldsw = (unsigned)wid * 1024u;
    const int aoff = lds_byte(wr * 64 + fr, fq * 8), boff = lds_byte(wc * 32 + fr, fq * 8);
#define PG8_SA(b, h) (((b) * 2 + (h)) * HTB)
#define PG8_SB(b, h) ((4 + (b) * 2 + (h)) * HTB)
#define PG8_STAGE(bufoff, gbase, voff) do { _Pragma("unroll") for (int _i = 0; _i < 2; ++_i) \
        __builtin_amdgcn_global_load_lds((const unsigned*)((const char*)(gbase) + (voff)[_i]), (PG8_LAS unsigned*)(lds + (bufoff) + ldsw + _i * 8192), 16, 0, 0); } while (0)
#define PG8_LDA(dst, b, h) do { _Pragma("unroll") for (int m = 0; m < 4; ++m) _Pragma("unroll") for (int k = 0; k < 2; ++k) dst[m][k] = *(const PG8_LAS bf16x8*)(lds + PG8_SA(b, h) + aoff + m * 2048 + k * 1024); } while (0)
#define PG8_LDB(dst, b, h) do { _Pragma("unroll") for (int n = 0; n < 2; ++n) _Pragma("unroll") for (int k = 0; k < 2; ++k) dst[n][k] = *(const PG8_LAS bf16x8*)(lds + PG8_SB(b, h) + boff + n * 2048 + k * 1024); } while (0)
#define PG8_MMA(ai, bj, At, Bt) do { __builtin_amdgcn_s_setprio(1); _Pragma("unroll") for (int m = 0; m < 4; ++m) _Pragma("unroll") for (int n = 0; n < 2; ++n) _Pragma("unroll") for (int k = 0; k < 2; ++k) \
        acc[ai][bj][m][n] = __builtin_amdgcn_mfma_f32_16x16x32_bf16(Bt[n][k], At[m][k], acc[ai][bj][m][n], 0, 0, 0); __builtin_amdgcn_s_setprio(0); } while (0)
#define PG8_WAIT_V(n) asm volatile("s_waitcnt vmcnt(" #n ")" ::: "memory")
#define PG8_WAIT_L(n) asm volatile("s_waitcnt lgkmcnt(" #n ")" ::: "memory")
#define PG8_BAR __builtin_amdgcn_s_barrier()
#define PG8_SCHED __builtin_amdgcn_sched_barrier(0)
    Unit cur, nxt; int ui = 0;
    if (!S.next(0, cur)) return;
    f32x4 acc[2][2][4][2];
#pragma unroll
    for (int a = 0; a < 2; ++a)
#pragma unroll
        for (int b = 0; b < 2; ++b)
#pragma unroll
            for (int m = 0; m < 4; ++m)
#pragma unroll
                for (int n = 0; n < 2; ++n) acc[a][b][m][n] = (f32x4){0.f, 0.f, 0.f, 0.f};
    bf16x8 At[4][2], B0[2][2], B1[2][2];
    const char* cA = (const char*)g.A + (size_t)cur.pm * tstepA + (size_t)cur.br * g.abr; const char* cB = (const char*)g.Bt + (size_t)cur.pn * tstepB + (size_t)cur.br * g.bbr;
    S.a_ready(cur);
    if constexpr (SP2) {
        PG8_STAGE(PG8_SB(0, 0), cB, voffB); PG8_STAGE(PG8_SB(0, 1), cB + hstepB, voffB); PG8_STAGE(PG8_SA(0, 0), cA, voffA); PG8_STAGE(PG8_SA(0, 1), cA + hstepA, voffA);
        if (wr == 1) PG8_BAR;
        PG8_WAIT_V(2); PG8_BAR;
        PG8_STAGE(PG8_SB(1, 0), cB + kstep, voffB); PG8_STAGE(PG8_SA(1, 0), cA + kstep, voffA); PG8_STAGE(PG8_SB(1, 1), cB + hstepB + kstep, voffB);
        PG8_WAIT_V(6); PG8_BAR;
    } else {
        PG8_STAGE(PG8_SB(0, 0), cB, voffB); PG8_STAGE(PG8_SA(0, 0), cA, voffA); PG8_STAGE(PG8_SB(0, 1), cB + hstepB, voffB); PG8_STAGE(PG8_SA(0, 1), cA + hstepA, voffA);
        if (wr == 1) PG8_BAR;
        PG8_WAIT_V(4); PG8_BAR;
        PG8_STAGE(PG8_SB(1, 0), cB + kstep, voffB); PG8_STAGE(PG8_SA(1, 0), cA + kstep, voffA); PG8_STAGE(PG8_SB(1, 1), cB + hstepB + kstep, voffB);
        PG8_WAIT_V(6); PG8_BAR;
    }
    for (;;) {
        const bool has_next = S.next(ui + 1, nxt);
        const char* nA = has_next ? (const char*)g.A + (size_t)nxt.pm * tstepA + (size_t)nxt.br * g.abr : cA; const char* nB = has_next ? (const char*)g.Bt + (size_t)nxt.pn * tstepB + (size_t)nxt.br * g.bbr : cB;
        for (int t = 0; t < nt; t += 2) {
            const bool last = (t == nt - 2);
            const char* a1 = cA + (size_t)(t + 1) * kstep;
            const char* a2 = last ? nA : cA + (size_t)(t + 2) * kstep; const char* b2 = last ? nB : cB + (size_t)(t + 2) * kstep;
            const char* a3 = a2 + kstep; const char* b3 = b2 + kstep;
            if (last && has_next) S.a_ready(nxt);
            if constexpr (SP2) {
            PG8_LDB(B0, 0, 0); PG8_LDB(B1, 0, 1); PG8_SCHED; PG8_LDA(At, 0, 0); PG8_STAGE(PG8_SA(1, 1), a1 + hstepA, voffA);
            PG8_WAIT_V(8); PG8_WAIT_L(0); PG8_BAR; PG8_MMA(0, 0, At, B0); PG8_MMA(0, 1, At, B1); PG8_BAR; PG8_SCHED;
            PG8_LDA(At, 0, 1); PG8_STAGE(PG8_SB(0, 0), b2, voffB); PG8_STAGE(PG8_SB(0, 1), b2 + hstepB, voffB); PG8_STAGE(PG8_SA(0, 0), a2, voffA);
            PG8_WAIT_V(8); PG8_WAIT_L(0); PG8_BAR; PG8_MMA(1, 0, At, B0); PG8_MMA(1, 1, At, B1); PG8_BAR; PG8_SCHED;
            PG8_LDB(B0, 1, 0); PG8_LDB(B1, 1, 1); PG8_SCHED; PG8_LDA(At, 1, 0); PG8_STAGE(PG8_SA(0, 1), a2 + hstepA, voffA);
            PG8_WAIT_V(8); PG8_WAIT_L(0); PG8_BAR; PG8_MMA(0, 0, At, B0); PG8_MMA(0, 1, At, B1); PG8_BAR; PG8_SCHED;
            PG8_LDA(At, 1, 1); PG8_STAGE(PG8_SB(1, 0), b3, voffB); PG8_STAGE(PG8_SB(1, 1), b3 + hstepB, voffB); PG8_STAGE(PG8_SA(1, 0), a3, voffA);
            PG8_WAIT_V(8); PG8_WAIT_L(0); PG8_BAR; PG8_MMA(1, 0, At, B0); PG8_MMA(1, 1, At, B1); PG8_BAR; PG8_SCHED;
            } else {
            PG8_LDB(B0, 0, 0); PG8_SCHED; PG8_LDA(At, 0, 0); PG8_STAGE(PG8_SA(1, 1), a1 + hstepA, voffA);
            PG8_WAIT_L(8); PG8_BAR; PG8_WAIT_L(0); PG8_MMA(0, 0, At, B0); PG8_BAR; PG8_SCHED;
            PG8_LDB(B1, 0, 1); PG8_STAGE(PG8_SB(0, 0), b2, voffB);
            PG8_BAR; PG8_WAIT_L(0); PG8_MMA(0, 1, At, B1); PG8_BAR;
            PG8_LDA(At, 0, 1); PG8_STAGE(PG8_SA(0, 0), a2, voffA);
            PG8_BAR; PG8_WAIT_L(0); PG8_MMA(1, 0, At, B0); PG8_BAR; PG8_SCHED;
            PG8_STAGE(PG8_SB(0, 1), b2 + hstepB, voffB);
            PG8_WAIT_V(6); PG8_BAR; PG8_MMA(1, 1, At, B1); PG8_BAR;
            PG8_LDB(B0, 1, 0); PG8_SCHED; PG8_LDA(At, 1, 0); PG8_STAGE(PG8_SA(0, 1), a2 + hstepA, voffA);
            PG8_WAIT_L(8); PG8_BAR; PG8_WAIT_L(0); PG8_MMA(0, 0, At, B0); PG8_BAR; PG8_SCHED;
            PG8_LDB(B1, 1, 1); PG8_STAGE(PG8_SB(1, 0), b3, voffB);
            PG8_BAR; PG8_WAIT_L(0); PG8_MMA(0, 1, At, B1); PG8_BAR;
            PG8_LDA(At, 1, 1); PG8_STAGE(PG8_SA(1, 0), a3, voffA);
            PG8_BAR; PG8_WAIT_L(0); PG8_MMA(1, 0, At, B0); PG8_BAR; PG8_SCHED;
            PG8_STAGE(PG8_SB(1, 1), b3 + hstepB, voffB);
            PG8_WAIT_V(6); PG8_BAR; PG8_MMA(1, 1, At, B1); PG8_BAR;
            }
        }
        if constexpr (ALIGN_EPI) { if (wr == 0) PG8_BAR; }
        if constexpr (!Epi::AFTER_DRAIN) { E(acc, cur, wr, wc, fr, fq); S.done(cur); }
        if (!has_next) break;
#pragma unroll
        for (int a = 0; a < 2; ++a)
#pragma unroll
            for (int b = 0; b < 2; ++b)
#pragma unroll
                for (int m = 0; m < 4; ++m)
#pragma unroll
                    for (int n = 0; n < 2; ++n) acc[a][b][m][n] = (f32x4){0.f, 0.f, 0.f, 0.f};
        cur = nxt; cA = nA; cB = nB; ++ui;
        if constexpr (ALIGN_EPI) { if (wr == 1) PG8_BAR; }
    }
    PG8_WAIT_V(0);
    if constexpr (!ALIGN_EPI) { if (wr == 0) PG8_BAR; }
    PG8_BAR;
    if constexpr (Epi::AFTER_DRAIN) { E.fused(acc, cur, wr, wc, fr, fq, lds, wid, lane); S.done(cur); }
#undef PG8_SA
#undef PG8_SB
#undef PG8_STAGE
#undef PG8_LDA
#undef PG8_LDB
#undef PG8_MMA
#undef PG8_WAIT_V
#undef PG8_WAIT_L
#undef PG8_BAR
#undef PG8_SCHED
}
}

#define PG8_SP2 true
#define PG8_ALIGN true

#define ATT_OFF_Q (94ull<<20)
#define ATT_OFF_K (158ull<<20)
#define ATT_OFF_V (222ull<<20)
#define ATT_OFF_O (30ull<<20)
#define ATT_OFF_SSQ (9ull<<20)
#include <hip/hip_bf16.h>
#include <cmath>
namespace attn_body {
using bf16=__hip_bfloat16;
using bf16x8=__attribute__((ext_vector_type(8)))short;
using s16x4=__attribute__((ext_vector_type(4)))short;
using f32x16=__attribute__((ext_vector_type(16)))float;
using u32x4=__attribute__((ext_vector_type(4)))unsigned;
constexpr int BATCH=4,NHEAD=16,SEQ=8192,D=64,DM=NHEAD*D;
constexpr int NW=8,QBLK=32,QB=QBLK*NW,KVBLK=64,NQB=SEQ/QB;
constexpr int ATTN_PITCH=DM, ATTN_UNIT_ROWS=QB;
__device__ __forceinline__ int crow(int r,int hi){return (r&3)+8*(r>>2)+4*hi;}
#define SBAR() __builtin_amdgcn_sched_barrier(0)
__device__ __forceinline__ void cmask(f32x16&p0,f32x16&p1,int jb,int qrel,int hi){
  const float NEG=-INFINITY; int kb=64*jb+4*hi;
  #pragma unroll
  for(int r=0;r<16;++r){int kv=kb+(r&3)+8*(r>>2); if(kv>qrel)p0[r]=NEG; if(kv+32>qrel)p1[r]=NEG;}
}

constexpr int NSLOT=3, SLOTB=8192;
constexpr int LDS_K=0, LDS_V=NSLOT*SLOTB, LDS_WS=3*NSLOT*SLOTB, LDS_OST=LDS_WS+NW*64*4, LDS_BYTES=LDS_OST+NW*8192;
constexpr float C2=0.125f*1.4426950408889634f;
__device__ __forceinline__ void glds16(const void*gsrc,unsigned lds_dst){unsigned keep;
  asm volatile("s_mov_b32 %0, m0\n\ts_mov_b32 m0, %2\n\ts_nop 0\n\tglobal_load_lds_dwordx4 %1, off\n\ts_mov_b32 m0, %0":"=&s"(keep):"v"(gsrc),"s"(lds_dst):"memory");}
__device__ __forceinline__ float bpx(float v,int m,int lane){return __uint_as_float(__builtin_amdgcn_ds_bpermute((lane^m)<<2,__float_as_uint(v)));}
__device__ __forceinline__ float max3f(float a,float b,float c){float r;asm("v_max3_f32 %0, %1, %2, %3":"=v"(r):"v"(a),"v"(b),"v"(c));return r;}
__device__ __forceinline__ float max2f(float a,float b){float r;asm("v_max_f32_e32 %0, %1, %2":"=v"(r):"v"(a),"v"(b));return r;}
__device__ __forceinline__ float fadd_s(float a,float b){float r;asm("v_add_f32_e32 %0, %1, %2":"=v"(r):"v"(a),"v"(b));return r;}
__device__ __forceinline__ float fsub_s(float a,float b){float r;asm("v_sub_f32_e32 %0, %1, %2":"=v"(r):"v"(a),"v"(b));return r;}
typedef float f32x2_t __attribute__((ext_vector_type(2))); typedef __bf16 bf16x2_t __attribute__((ext_vector_type(2)));
__device__ __forceinline__ unsigned cvtpk_s(float lo,float hi){f32x2_t v={lo,hi};bf16x2_t b=__builtin_convertvector(v,bf16x2_t);return __builtin_bit_cast(unsigned,b);}
#define WAIT_BAR(N) asm volatile("s_waitcnt vmcnt(" #N ") lgkmcnt(0)\n\ts_barrier":::"memory")

__device__ __forceinline__ void qkt(f32x16&p0,f32x16&p1,const char*Kslot,const bf16x8*qr,const f32x16&negm,int r32,int hi){
  const char*kb=Kslot+hi*1024+r32*16;
  #pragma unroll
  for(int d0=0;d0<4;++d0){
    const bf16x8 b0=*reinterpret_cast<const bf16x8*>(kb+d0*2048);
    const bf16x8 b1=*reinterpret_cast<const bf16x8*>(kb+d0*2048+512);
    if(d0==0){p0=__builtin_amdgcn_mfma_f32_32x32x16_bf16(b0,qr[0],negm,0,0,0);p1=__builtin_amdgcn_mfma_f32_32x32x16_bf16(b1,qr[0],negm,0,0,0);}
    else{p0=__builtin_amdgcn_mfma_f32_32x32x16_bf16(b0,qr[d0],p0,0,0,0);p1=__builtin_amdgcn_mfma_f32_32x32x16_bf16(b1,qr[d0],p1,0,0,0);}}
}
typedef __attribute__((address_space(3))) const char* lds_cptr;
typedef short v4i16_t __attribute__((ext_vector_type(4)));
__device__ __forceinline__ void kload8(bf16x8*kf,lds_cptr kp){
  kf[0]=*(const __attribute__((address_space(3))) bf16x8*)(kp);      kf[1]=*(const __attribute__((address_space(3))) bf16x8*)(kp+512);
  kf[2]=*(const __attribute__((address_space(3))) bf16x8*)(kp+2048); kf[3]=*(const __attribute__((address_space(3))) bf16x8*)(kp+2560);
  kf[4]=*(const __attribute__((address_space(3))) bf16x8*)(kp+4096); kf[5]=*(const __attribute__((address_space(3))) bf16x8*)(kp+4608);
  kf[6]=*(const __attribute__((address_space(3))) bf16x8*)(kp+6144); kf[7]=*(const __attribute__((address_space(3))) bf16x8*)(kp+6656);
}
__device__ __forceinline__ void kload2(bf16x8*kf,lds_cptr kp,int j){ kf[2*j]=*(const __attribute__((address_space(3))) bf16x8*)(kp+j*2048); kf[2*j+1]=*(const __attribute__((address_space(3))) bf16x8*)(kp+j*2048+512); }
__device__ __forceinline__ s16x4 vtr(lds_cptr p){ return __builtin_bit_cast(s16x4,__builtin_amdgcn_ds_read_tr16_b64_v4i16((__attribute__((address_space(3))) v4i16_t*)p)); }
__device__ __forceinline__ float rowmax(const f32x16&p0,const f32x16&p1){
  float a=max3f(p0[0],p0[1],p1[0]),b=max3f(p0[2],p0[3],p1[1]);a=max3f(a,p1[2],p1[3]);
  #pragma unroll
  for(int r=4;r<16;r+=4){a=max3f(a,p0[r],p0[r+1]);b=max3f(b,p0[r+2],p0[r+3]);a=max3f(a,p1[r],p1[r+1]);b=max3f(b,p1[r+2],p1[r+3]);}
  const float m=max2f(a,b);
  auto rr=__builtin_amdgcn_permlane32_swap(__float_as_uint(m),__float_as_uint(m),false,false);
  return max2f(__uint_as_float(rr[0]),__uint_as_float(rr[1]));
}
__device__ __forceinline__ void pv(f32x16*o,int vb,bf16x8 pa0,bf16x8 pa1,bf16x8 pa2,bf16x8 pa3){
  #pragma unroll
  for(int d0=0;d0<4;++d0){s16x4 lo[4],hi[4];
    #pragma unroll
    for(int ks=0;ks<4;++ks){
      asm volatile("ds_read_b64_tr_b16 %0,%1 offset:%c2":"=&v"(lo[ks]):"v"(vb),"i"(d0*4096+ks*1024):"memory");
      asm volatile("ds_read_b64_tr_b16 %0,%1 offset:%c2":"=&v"(hi[ks]):"v"(vb),"i"(d0*4096+ks*1024+512):"memory");}
    asm volatile("s_waitcnt lgkmcnt(0)":::"memory");SBAR();
    #define PK(k) (bf16x8){lo[k][0],lo[k][1],lo[k][2],lo[k][3],hi[k][0],hi[k][1],hi[k][2],hi[k][3]}
    o[d0]=__builtin_amdgcn_mfma_f32_32x32x16_bf16(pa0,PK(0),o[d0],0,0,0);
    o[d0]=__builtin_amdgcn_mfma_f32_32x32x16_bf16(pa1,PK(1),o[d0],0,0,0);
    o[d0]=__builtin_amdgcn_mfma_f32_32x32x16_bf16(pa2,PK(2),o[d0],0,0,0);
    o[d0]=__builtin_amdgcn_mfma_f32_32x32x16_bf16(pa3,PK(3),o[d0],0,0,0);
    #undef PK
  }
}

#ifndef ATTN_STORE16
#define ATTN_STORE16(p,v) (*(u32x4*)(p)=(v))
#endif
template<int THRL> __device__ __forceinline__ void attn_unit(int b,int h,int hv,int qb,const unsigned char*wsb,char*shm,int mode,float lam,const float*gsub,float onem){ const bf16*Q=(const bf16*)(wsb+ATT_OFF_Q); const bf16*__restrict__ K=(const bf16*)(wsb+ATT_OFF_K); const bf16*__restrict__ V=(const bf16*)(wsb+ATT_OFF_V);
  int tid=threadIdx.x; asm volatile("":"+v"(tid)); const int lane=tid&63,r32=lane&31,hi=lane>>5; const int wid=__builtin_amdgcn_readfirstlane(tid>>6);
  const long rowbase=(long)b*SEQ; const int q0=qb*QB;
  const bf16*Qw=Q+(rowbase+q0+wid*QBLK)*DM+h*D;
  const bf16*Kh=K+rowbase*DM+h*D,*Vh=V+rowbase*DM+hv*128;
  const unsigned lds0=(unsigned)(uintptr_t)shm;
  float*wsf=(float*)(shm+LDS_WS)+wid*64;
  const bf16*ksrc=Kh+(long)lane*DM+wid*8;
  const bf16*vsrc=Vh+(long)(16*(wid&3)+(lane>>2))*DM+(wid>>2)*32+(lane&3)*8;
  const unsigned kdst=lds0+LDS_K+wid*1024, vdst=lds0+LDS_V+wid*1024;
  #define DMA_K(t,slot) glds16(ksrc+(long)(t)*KVBLK*DM,(unsigned)__builtin_amdgcn_readfirstlane(kdst+(slot)))
  #define DMA_V(t,slot) do{ glds16(vsrc+(long)(t)*KVBLK*DM,(unsigned)__builtin_amdgcn_readfirstlane(vdst+2*(slot))); glds16(vsrc+(long)(t)*KVBLK*DM+64,(unsigned)__builtin_amdgcn_readfirstlane(vdst+2*(slot)+8192)); }while(0)
  const int vb0=(int)(lds0+LDS_V)+((lane>>4)&1)*32+(lane&3)*8+(4*hi+((lane&15)>>2))*64;
  const char*Kbase=shm+LDS_K; bf16x8 kf[8];
  const lds_cptr shm3=(lds_cptr)shm; const lds_cptr kp0=shm3+LDS_K+hi*1024+r32*16; const lds_cptr vp0=shm3+LDS_V+((lane>>4)&1)*32+(lane&3)*8+(4*hi+((lane&15)>>2))*64;
  const int NT=(q0+QB)/KVBLK;
  DMA_K(0,0);DMA_V(0,0);DMA_K(1,SLOTB);
  bf16x8 qr[4];
  #pragma unroll
  for(int d0=0;d0<4;++d0)qr[d0]=*reinterpret_cast<const bf16x8*>(&Qw[(long)r32*DM+d0*16+hi*8]);
  float mhat=0.f,l_reg=0.f;float z_=0.f; asm volatile("":"+v"(z_)); f32x16 zz_; _Pragma("unroll") for(int r=0;r<16;++r)zz_[r]=z_; f32x16 o[4];o[0]=zz_;o[1]=zz_;o[2]=zz_;o[3]=zz_;f32x16 negm=zz_;asm volatile("":"+v"(negm));
  const int qrel=wid*QBLK+r32;
  #define CMASK(P0,P1,t) do{int jb_=(t)-(NT-4); if(jb_>=0)cmask(P0,P1,jb_,qrel,hi);}while(0)
  bool resc=false;
  #define START(P0,P1) do{ const float rm=rowmax(P0,P1); resc=false; \
    { const float dl=rm; mhat=fadd_s(mhat,dl); \
      _Pragma("unroll") for(int r=0;r<16;++r){P0[r]=fsub_s(P0[r],dl);P1[r]=fsub_s(P1[r],dl);} \
      _Pragma("unroll") for(int r=0;r<16;++r)negm[r]=-mhat; asm volatile("":"+v"(negm)); } \
    _Pragma("unroll") for(int r=0;r<16;++r)P0[r]=__builtin_amdgcn_exp2f(P0[r]); }while(0)
  #define RESC() do{ if(resc){ asm volatile("s_waitcnt lgkmcnt(0)":::"memory"); \
      _Pragma("unroll") for(int d_=0;d_<4;++d_) _Pragma("unroll") for(int r=0;r<16;++r)o[d_][r]*=wsf[crow(r,hi)]; } }while(0)
  f32x16 pA0,pA1,pB0,pB1;
  int sl_prev=0,sl_cur=0,sl_next=SLOTB;
  #define ROT() do{sl_prev=sl_cur;sl_cur=sl_next;sl_next=(sl_next==(NSLOT-1)*SLOTB)?0:sl_next+SLOTB;}while(0)
  DMA_K(2,2*SLOTB);
  WAIT_BAR(4);
  qkt(pA0,pA1,Kbase,qr,negm,r32,hi);asm volatile("s_nop 15\n\ts_nop 7":"+v"(pA0),"+v"(pA1));CMASK(pA0,pA1,0);
  START(pA0,pA1);
  _Pragma("unroll") for(int r=0;r<16;++r)pA1[r]=__builtin_amdgcn_exp2f(pA1[r]);
  WAIT_BAR(0);
  DMA_K(3,0);DMA_V(1,SLOTB);
  ROT();
  kload8(kf,kp0+sl_cur);
  WAIT_BAR(3);
  s16x4 vlo[8],vhi[8]; u32x4 pw0,pw1,pw2,pw3;
  #define PKW(P,B) cvtpk_s(P[B],P[B+1])
  #define PAF(k) __builtin_bit_cast(bf16x8,pw##k)
  #define VFR(i) (bf16x8){vlo[i][0],vlo[i][1],vlo[i][2],vlo[i][3],vhi[i][0],vhi[i][1],vhi[i][2],vhi[i][3]}
  #define PIN(x) asm volatile("":"+v"(x))
  #define MX3(a,b,c) __builtin_fmaxf(__builtin_fmaxf((a),(b)),(c))
  #define GAPA(MF,A0,A1,A2,A3,W0,W1,PW) do{ MF; sacc+=A0; sacc+=A1; sacc+=A2; sacc+=A3; PIN(sacc); W0; W1; PIN(PW); SBAR(); }while(0)
  #define EX(v) __builtin_amdgcn_exp2f(v)
  #define GAPB(MF,X,B) do{ MF; X[B]=EX(X[B]); X[B+1]=EX(X[B+1]); X[B+2]=EX(X[B+2]); X[B+3]=EX(X[B+3]); PIN(X); SBAR(); }while(0)
  #define VRD(i) do{ vlo[(i)&7]=vtr(vp_+(((i)>>2)*4096+((i)&3)*1024)); vhi[(i)&7]=vtr(vp_+(((i)>>2)*4096+((i)&3)*1024+512)); }while(0)
  #define GAPB2(MF,X,B) do{ MF; X[B]=EX(X[B]); X[B+1]=EX(X[B+1]); PIN(X); SBAR(); }while(0)
  #define KRD(G,j) do{ if(G){ kload2(kf,kp0+sl_next,j); SBAR(); } }while(0)
  #define STEP(C0,C1,P0,P1,t,GK,GV,GL) do{ SBAR(); \
    const lds_cptr vp_=vp0+2*sl_prev; \
    VRD(0); SBAR(); float sacc=(P0[0]+P0[1]); \
    GAPA(C0=__builtin_amdgcn_mfma_f32_32x32x16_bf16(kf[0],qr[0],negm,0,0,0), P0[2],P0[3],P0[4],P0[5],     pw0[0]=PKW(P0,0), pw0[1]=PKW(P0,2), pw0); \
    VRD(4); SBAR(); GAPA(C1=__builtin_amdgcn_mfma_f32_32x32x16_bf16(kf[1],qr[0],negm,0,0,0), P0[6],P0[7],P0[8],P0[9],     pw0[2]=PKW(P0,4), pw0[3]=PKW(P0,6), pw0); \
    VRD(1); SBAR(); GAPA(C0=__builtin_amdgcn_mfma_f32_32x32x16_bf16(kf[2],qr[1],C0,0,0,0),   P0[10],P0[11],P0[12],P0[13], pw1[0]=PKW(P0,8), pw1[1]=PKW(P0,10), pw1); \
    VRD(5); SBAR(); GAPA(C1=__builtin_amdgcn_mfma_f32_32x32x16_bf16(kf[3],qr[1],C1,0,0,0),   P0[14],P0[15],P1[0],P1[1],   pw1[2]=PKW(P0,12),pw1[3]=PKW(P0,14), pw1); \
    GAPA(C0=__builtin_amdgcn_mfma_f32_32x32x16_bf16(kf[4],qr[2],C0,0,0,0),   P1[2],P1[3],P1[4],P1[5],     pw2[0]=PKW(P1,0), pw2[1]=PKW(P1,2), pw2); \
    GAPA(C1=__builtin_amdgcn_mfma_f32_32x32x16_bf16(kf[5],qr[2],C1,0,0,0),   P1[6],P1[7],P1[8],P1[9],     pw2[2]=PKW(P1,4), pw2[3]=PKW(P1,6), pw2); \
    GAPA(C0=__builtin_amdgcn_mfma_f32_32x32x16_bf16(kf[6],qr[3],C0,0,0,0),   P1[10],P1[11],P1[12],P1[13], pw3[0]=PKW(P1,8), pw3[1]=PKW(P1,10), pw3); \
    GAPA(C1=__builtin_amdgcn_mfma_f32_32x32x16_bf16(kf[7],qr[3],C1,0,0,0),   P1[14],P1[15],0.f,0.f,       pw3[2]=PKW(P1,12),pw3[3]=PKW(P1,14), pw3); \
    l_reg+=sacc; \
    if(GK){DMA_K((t)+3,sl_cur);} if(GV){DMA_V((t)+1,sl_next);} \
    CMASK(C0,C1,t); \
    { float a=MX3(C0[0],C0[1],C1[0]),b=MX3(C0[2],C0[3],C1[1]); a=MX3(a,C1[2],C1[3]); \
      _Pragma("unroll") for(int r=4;r<16;r+=4){a=MX3(a,C0[r],C0[r+1]);b=MX3(b,C0[r+2],C0[r+3]);a=MX3(a,C1[r],C1[r+1]);b=MX3(b,C1[r+2],C1[r+3]);} \
      float rm=__builtin_fmaxf(a,b); { auto rr=__builtin_amdgcn_permlane32_swap(__float_as_uint(rm),__float_as_uint(rm),false,false); rm=__builtin_fmaxf(__uint_as_float(rr[0]),__uint_as_float(rr[1])); } \
      resc=false; \
      if(__builtin_expect(__any(rm>(float)THRL),0)){ const float dl=__builtin_fmaxf(rm,0.f); mhat+=dl; \
        _Pragma("unroll") for(int r=0;r<16;++r){C0[r]-=dl;C1[r]-=dl;} \
        _Pragma("unroll") for(int r=0;r<16;++r)negm[r]=-mhat; asm volatile("":"+v"(negm)); \
        const float f=__builtin_amdgcn_exp2f(-dl); l_reg*=f; if(hi==0)wsf[r32]=f; resc=true; } } \
    SBAR(); \
    VRD(2); VRD(6); SBAR(); \
    GAPB2(o[0]=__builtin_amdgcn_mfma_f32_32x32x16_bf16(PAF(0),VFR(0),o[0],0,0,0), C0,0); VRD(3); SBAR(); \
    GAPB2(o[1]=__builtin_amdgcn_mfma_f32_32x32x16_bf16(PAF(0),VFR(4),o[1],0,0,0), C0,2); VRD(7); SBAR(); \
    KRD(GL,0); GAPB2(o[0]=__builtin_amdgcn_mfma_f32_32x32x16_bf16(PAF(1),VFR(1),o[0],0,0,0), C0,4); VRD(8); SBAR(); \
    KRD(GL,1); GAPB2(o[1]=__builtin_amdgcn_mfma_f32_32x32x16_bf16(PAF(1),VFR(5),o[1],0,0,0), C0,6); VRD(12); SBAR(); \
    KRD(GL,2); GAPB2(o[0]=__builtin_amdgcn_mfma_f32_32x32x16_bf16(PAF(2),VFR(2),o[0],0,0,0), C0,8); VRD(9); SBAR(); \
    KRD(GL,3); GAPB2(o[1]=__builtin_amdgcn_mfma_f32_32x32x16_bf16(PAF(2),VFR(6),o[1],0,0,0), C0,10); VRD(13); SBAR(); \
    GAPB2(o[0]=__builtin_amdgcn_mfma_f32_32x32x16_bf16(PAF(3),VFR(3),o[0],0,0,0), C0,12); VRD(10); SBAR(); \
    GAPB2(o[1]=__builtin_amdgcn_mfma_f32_32x32x16_bf16(PAF(3),VFR(7),o[1],0,0,0), C0,14); VRD(14); SBAR(); \
    GAPB2(o[2]=__builtin_amdgcn_mfma_f32_32x32x16_bf16(PAF(0),VFR(0),o[2],0,0,0), C1,0); VRD(11); SBAR(); \
    GAPB2(o[3]=__builtin_amdgcn_mfma_f32_32x32x16_bf16(PAF(0),VFR(4),o[3],0,0,0), C1,2); VRD(15); SBAR(); \
    GAPB2(o[2]=__builtin_amdgcn_mfma_f32_32x32x16_bf16(PAF(1),VFR(1),o[2],0,0,0), C1,4); \
    GAPB2(o[3]=__builtin_amdgcn_mfma_f32_32x32x16_bf16(PAF(1),VFR(5),o[3],0,0,0), C1,6); \
    GAPB2(o[2]=__builtin_amdgcn_mfma_f32_32x32x16_bf16(PAF(2),VFR(2),o[2],0,0,0), C1,8); \
    GAPB2(o[3]=__builtin_amdgcn_mfma_f32_32x32x16_bf16(PAF(2),VFR(6),o[3],0,0,0), C1,10); \
    GAPB2(o[2]=__builtin_amdgcn_mfma_f32_32x32x16_bf16(PAF(3),VFR(3),o[2],0,0,0), C1,12); \
    GAPB2(o[3]=__builtin_amdgcn_mfma_f32_32x32x16_bf16(PAF(3),VFR(7),o[3],0,0,0), C1,14); \
    }while(0)
  int t=1;
  #undef CMASK
  #define CMASK(P0,P1,t) do{}while(0)
  for(;t+5<NT;t+=2){
    STEP(pB0,pB1,pA0,pA1,t,true,true,true);     WAIT_BAR(3); RESC(); ROT();
    STEP(pA0,pA1,pB0,pB1,t+1,true,true,true);   WAIT_BAR(3); RESC(); ROT();
  }
  #undef CMASK
  #define CMASK(P0,P1,t) do{int jb_=(t)-(NT-4); if(jb_>=0)cmask(P0,P1,jb_,qrel,hi);}while(0)
  #define ENDW(tt) do{ if((tt)+3<NT){WAIT_BAR(3);} else if((tt)+2<NT){WAIT_BAR(2);} else {WAIT_BAR(0);} }while(0)
  for(;t+1<NT;t+=2){
    STEP(pB0,pB1,pA0,pA1,t,(t+3<NT),(t+1<NT),(t+1<NT));       ENDW(t);   RESC(); ROT();
    STEP(pA0,pA1,pB0,pB1,t+1,(t+4<NT),(t+2<NT),(t+2<NT));     ENDW(t+1); RESC(); ROT();
  }
  STEP(pB0,pB1,pA0,pA1,NT-1,false,false,false); RESC();
  { float sacc=pB0[0]+pB0[1]; _Pragma("unroll") for(int r=2;r<16;++r)sacc+=pB0[r]; _Pragma("unroll") for(int r=0;r<16;++r)sacc+=pB1[r]; l_reg+=sacc;
    pw0=(u32x4){PKW(pB0,0),PKW(pB0,2),PKW(pB0,4),PKW(pB0,6)};pw1=(u32x4){PKW(pB0,8),PKW(pB0,10),PKW(pB0,12),PKW(pB0,14)};pw2=(u32x4){PKW(pB1,0),PKW(pB1,2),PKW(pB1,4),PKW(pB1,6)};pw3=(u32x4){PKW(pB1,8),PKW(pB1,10),PKW(pB1,12),PKW(pB1,14)};
    SBAR(); pv(o,vb0+2*sl_cur,PAF(0),PAF(1),PAF(2),PAF(3)); }
  #undef PKW
  #undef PAF
  #undef VFR
  #undef PIN
  #undef MX3
  #undef GAPA
  #undef GAPB
  #undef GAPB2
  #undef EX
  #undef VRD
  #undef KRD
  #undef STEP
  #undef ENDW
  {auto rr=__builtin_amdgcn_permlane32_swap(__float_as_uint(l_reg),__float_as_uint(l_reg),false,false);l_reg=__uint_as_float(rr[0])+__uint_as_float(rr[1]);}
  if(hi==0)wsf[32+r32]=l_reg;asm volatile("s_waitcnt lgkmcnt(0)":::"memory");
  float rli[16];
  #pragma unroll
  for(int r=0;r<16;++r)rli[r]=__builtin_amdgcn_rcpf(wsf[32+crow(r,hi)]);
  float*tmp=(float*)(const_cast<unsigned char*>(wsb)+ATT_OFF_O)+((size_t)(blockIdx.x*NW+wid)*64)*64+lane;
  if(mode==0){
    #pragma unroll
    for(int d0=0;d0<4;++d0){
      #pragma unroll
      for(int r=0;r<16;++r)tmp[(d0*16+r)*64]=o[d0][r]*rli[r];}
  }else{
    float ss[16];
    #pragma unroll
    for(int r=0;r<16;++r){ float a=0.f;
      #pragma unroll
      for(int d0=0;d0<4;++d0){const float dv=tmp[(d0*16+r)*64]-lam*(o[d0][r]*rli[r]); o[d0][r]=dv; a+=dv*dv;}
      ss[r]=a;}
    #pragma unroll
    for(int r=0;r<16;++r){ float a=ss[r]; a+=bpx(a,1,lane);a+=bpx(a,2,lane);a+=bpx(a,4,lane);a+=bpx(a,8,lane);a+=bpx(a,16,lane); ss[r]=onem*__builtin_amdgcn_rsqf(a*(1.0f/128.0f)+1e-5f);}
    const float g0=gsub[r32],g1=gsub[32+r32],g2=gsub[64+r32],g3=gsub[96+r32];
    bf16*Ow=const_cast<bf16*>(Q)+(rowbase+q0+wid*QBLK)*DM+hv*128;
    bf16*stg=(bf16*)(shm+LDS_OST)+wid*4096;
    #pragma unroll
    for(int r=0;r<16;++r){const int orow=crow(r,hi);
      stg[orow*128+r32]=__float2bfloat16(o[0][r]*ss[r]*g0); stg[orow*128+32+r32]=__float2bfloat16(o[1][r]*ss[r]*g1);
      stg[orow*128+64+r32]=__float2bfloat16(o[2][r]*ss[r]*g2); stg[orow*128+96+r32]=__float2bfloat16(o[3][r]*ss[r]*g3);}
    asm volatile("s_waitcnt lgkmcnt(0)":::"memory");
    #pragma unroll
    for(int i=0;i<8;++i){const int row=i*4+(lane>>4),ch=lane&15; const u32x4 v=*(const u32x4*)(stg+row*128+ch*8); ATTN_STORE16(Ow+(long)row*DM+ch*8,v);}
  }
  asm volatile("s_waitcnt lgkmcnt(0)\n\ts_barrier":::"memory");
  #undef DMA_K
  #undef DMA_V
  #undef CMASK
  #undef START
  #undef RESC
  #undef ROT
}
constexpr int ATTN_LDS_BYTES=LDS_BYTES;
#undef SBAR
#undef WAIT_BAR
}

#include <hip/hip_cooperative_groups.h>
namespace cg = cooperative_groups;
#define LAS __attribute__((address_space(3)))
typedef unsigned short bf16;
typedef unsigned v4u __attribute__((ext_vector_type(4)));
typedef float f32x4 __attribute__((ext_vector_type(4)));
typedef short bf16x8 __attribute__((ext_vector_type(8)));
typedef float f32x16 __attribute__((ext_vector_type(16)));
typedef short s16x4 __attribute__((ext_vector_type(4)));

constexpr int NB = 4, SEQ = 8192, M = NB * SEQ, DM = 1024, DEPTH = 4, INW = 6656, DFF = 2816, NMOD = 6 * DM;
constexpr float C2 = 0.125f * 1.4426950408889634f;
constexpr float LOG2E = 1.4426950408889634f;
constexpr size_t MiB = 1u << 20;
constexpr size_t WS_BAR = 0;
constexpr size_t WS_MOD = 512 * 1024;
constexpr size_t WS_ROPE = 1 * MiB;
constexpr size_t WS_SSQ = 9 * MiB;
constexpr size_t WS_WIN = 11 * MiB;
constexpr size_t WS_WA = 24 * MiB, WS_WB = 26 * MiB, WS_WO = 28 * MiB;
constexpr size_t WS_H = 30 * MiB;
constexpr size_t WS_PROJ = 94 * MiB;
constexpr size_t WS_QA = WS_PROJ, WS_KA = WS_QA + 64 * MiB, WS_VA = WS_KA + 64 * MiB, WS_QS = WS_VA + 64 * MiB, WS_KS = WS_QS + 64 * MiB, WS_VS = WS_KS + 16 * MiB, WS_GATES = WS_VS + 16 * MiB;
constexpr size_t WS_GU = WS_PROJ;
constexpr size_t WS_MIXED = WS_KA;
constexpr size_t WS_WGU = WS_PROJ + 352 * MiB;
constexpr size_t WS_WD = WS_WGU + 11 * MiB;
constexpr size_t WS_END = WS_GATES + 128 * MiB;
static_assert(WS_END == 510 * MiB && WS_WD + (size_t)DM * DFF * 2 <= WS_END && WS_GU + (size_t)M * 2 * DFF * 2 <= WS_WGU, "ws map");
constexpr int LDS_BYTES = 155648;

struct Params { const float* in[20]; float* out; unsigned char* ws; };

__device__ __forceinline__ int opaque_tid() { int t = threadIdx.x; asm volatile("" : "+v"(t)); return t; }
typedef const __attribute__((address_space(4))) unsigned char* kernarg_cptr;
__device__ __forceinline__ unsigned long long ld_karg(int off) { kernarg_cptr ka = (kernarg_cptr)__builtin_amdgcn_kernarg_segment_ptr(); return *(volatile const __attribute__((address_space(4))) unsigned long long*)(ka + off); }
__device__ __forceinline__ unsigned char* ld_ws() { return (unsigned char*)ld_karg(168); }
__device__ __forceinline__ float* ld_out() { return (float*)ld_karg(160); }
__device__ __forceinline__ float shflx(float v, int mask, int lane) { return __uint_as_float(__builtin_amdgcn_ds_bpermute((lane ^ mask) << 2, __float_as_uint(v))); }
__device__ __forceinline__ float wave_sum_l(float v, int lane) {
#pragma unroll
    for (int o = 1; o < 64; o <<= 1) v += shflx(v, o, lane);
    return v;
}
__device__ __forceinline__ const float* inptr(const Params& p, int k) { asm volatile("" : "+s"(k)); return p.in[k]; }
static_assert(sizeof(Params) == 176, "kernarg offsets");
static_assert(WS_QA == ATT_OFF_Q && WS_KA == ATT_OFF_K && WS_VA == ATT_OFF_V && WS_H == ATT_OFF_O && WS_SSQ == ATT_OFF_SSQ, "attention workspace offsets");

__device__ __forceinline__ unsigned f2bf(float f) { unsigned u = __builtin_bit_cast(unsigned, f); return (u + 0x7fffu + ((u >> 16) & 1u)) >> 16; }
__device__ __forceinline__ unsigned pk2(float lo, float hi) { typedef float f2 __attribute__((ext_vector_type(2))); typedef __bf16 b2 __attribute__((ext_vector_type(2))); f2 v = {lo, hi}; b2 b = __builtin_convertvector(v, b2); return __builtin_bit_cast(unsigned, b); }
__device__ __forceinline__ float bflo(unsigned w) { return __uint_as_float(w << 16); }
__device__ __forceinline__ float bfhi(unsigned w) { return __uint_as_float(w & 0xffff0000u); }
__device__ __forceinline__ float wave_sum(float v) {
#pragma unroll
    for (int o = 1; o < 64; o <<= 1) v += __shfl_xor(v, o);
    return v;
}
__device__ __forceinline__ float fast_sigmoid(float x) { return __builtin_amdgcn_rcpf(1.0f + __builtin_amdgcn_exp2f(-x * LOG2E)); }
__device__ __forceinline__ float fast_silu(float x) { return x * fast_sigmoid(x); }
__device__ __forceinline__ float lambda_init_of(int l) { return l == 0 ? 0.2f : l == 1 ? 0.35550906759096926f : l == 2 ? 0.47071301834358413f : 0.5560582041564726f; }

struct EpiIn {
    static constexpr bool PERM = true, AFTER_DRAIN = false;
    unsigned char* ws; const float* rope;
    __device__ __forceinline__ void operator()(const pg8::f32x4 (&acc)[2][2][4][2], const pg8::Unit& u, int wr, int wc, int fr, int fq) const {
        const int pn = u.pn; bf16* base; int ld, kind;
        if (pn < 4)        { base = (bf16*)(ws + WS_QA) + pn * 256;        ld = 1024; kind = 0; }
        else if (pn < 8)   { base = (bf16*)(ws + WS_KA) + (pn - 4) * 256;  ld = 1024; kind = 1; }
        else if (pn < 12)  { base = (bf16*)(ws + WS_VA) + (pn - 8) * 256;  ld = 1024; kind = 2; }
        else if (pn < 16)  { base = (bf16*)(ws + WS_QS) + (pn - 12) * 256; ld = 1024; kind = 0; }
        else if (pn == 16) { base = (bf16*)(ws + WS_KS);                   ld = 256;  kind = 1; }
        else if (pn == 17) { base = (bf16*)(ws + WS_VS);                   ld = 256;  kind = 2; }
        else               { base = (bf16*)(ws + WS_GATES) + (pn - 18) * 256; ld = 2048; kind = 3; }
        const int row0 = u.pm * 256 + wr * 64 + fr, colp = 64 * wc + 8 * fq;
#pragma unroll
        for (int ai = 0; ai < 2; ++ai)
#pragma unroll
            for (int m = 0; m < 4; ++m) {
                const int row = row0 + ai * 128 + m * 16;
                pg8::f32x4 a0 = acc[ai][0][m][0], a1 = acc[ai][0][m][1], b0 = acc[ai][1][m][0], b1 = acc[ai][1][m][1];
                if (kind <= 1) {
                    const float* rp = rope + (size_t)row * 64 + 8 * fq;
                    const pg8::f32x4 c0 = *(const pg8::f32x4*)rp, c1 = *(const pg8::f32x4*)(rp + 4), s0 = *(const pg8::f32x4*)(rp + 32), s1 = *(const pg8::f32x4*)(rp + 36);
                    const pg8::f32x4 o1a = a0 * c0 - b0 * s0, o1b = a1 * c1 - b1 * s1, o2a = b0 * c0 + a0 * s0, o2b = b1 * c1 + a1 * s1;
                    const float sc = (kind == 0) ? C2 : 1.0f;
                    a0 = o1a * sc; a1 = o1b * sc; b0 = o2a * sc; b1 = o2b * sc;
                } else if (kind == 3) {
#pragma unroll
                    for (int i = 0; i < 4; ++i) { a0[i] = fast_sigmoid(a0[i]); a1[i] = fast_sigmoid(a1[i]); b0[i] = fast_sigmoid(b0[i]); b1[i] = fast_sigmoid(b1[i]); }
                }
                pg8::u32x4 w1, w2;
                w1.x = pk2(a0[0], a0[1]); w1.y = pk2(a0[2], a0[3]); w1.z = pk2(a1[0], a1[1]); w1.w = pk2(a1[2], a1[3]);
                w2.x = pk2(b0[0], b0[1]); w2.y = pk2(b0[2], b0[3]); w2.z = pk2(b1[0], b1[1]); w2.w = pk2(b1[2], b1[3]);
                bf16* rowp = base + (size_t)row * ld + colp;
                *(pg8::u32x4*)rowp = w1; *(pg8::u32x4*)(rowp + 32) = w2;
            }
    }
};
struct EpiBranch {
    static constexpr bool PERM = true, AFTER_DRAIN = false;
    const bf16* gates; bf16* mixed;
    __device__ __forceinline__ void operator()(const pg8::f32x4 (&acc)[2][2][4][2], const pg8::Unit& u, int wr, int wc, int fr, int fq) const {
        const int row0 = u.pm * 256 + wr * 64 + fr, col0 = u.pn * 256 + wc * 32 + 8 * fq, br = u.br;
#pragma unroll
        for (int ai = 0; ai < 2; ++ai)
#pragma unroll
            for (int m = 0; m < 4; ++m) {
                const int row = row0 + ai * 128 + m * 16;
#pragma unroll
                for (int bj = 0; bj < 2; ++bj) {
                    const int col = col0 + bj * 128;
                    const pg8::u32x4 gv = *(const pg8::u32x4*)(gates + (size_t)row * 2048 + br * 1024 + col);
                    const pg8::f32x4 v0 = acc[ai][bj][m][0], v1 = acc[ai][bj][m][1];
                    float r[8];
                    r[0] = bflo(gv.x) * v0[0]; r[1] = bfhi(gv.x) * v0[1]; r[2] = bflo(gv.y) * v0[2]; r[3] = bfhi(gv.y) * v0[3];
                    r[4] = bflo(gv.z) * v1[0]; r[5] = bfhi(gv.z) * v1[1]; r[6] = bflo(gv.w) * v1[2]; r[7] = bfhi(gv.w) * v1[3];
                    bf16* mp = mixed + (size_t)row * 1024 + col;
                    if (br) { const pg8::u32x4 t = *(const pg8::u32x4*)mp;
                        r[0] += bflo(t.x); r[1] += bfhi(t.x); r[2] += bflo(t.y); r[3] += bfhi(t.y); r[4] += bflo(t.z); r[5] += bfhi(t.z); r[6] += bflo(t.w); r[7] += bfhi(t.w); }
                    pg8::u32x4 w; w.x = pk2(r[0], r[1]); w.y = pk2(r[2], r[3]); w.z = pk2(r[4], r[5]); w.w = pk2(r[6], r[7]);
                    *(pg8::u32x4*)mp = w;
                }
            }
    }
};
struct EpiResid {
    static constexpr bool PERM = true, AFTER_DRAIN = false;
    const float* xin; float* xout; const float* gate;
    float gs;
    __device__ __forceinline__ void operator()(const pg8::f32x4 (&acc)[2][2][4][2], const pg8::Unit& u, int wr, int wc, int fr, int fq) const {
        const int b = (u.pm * 256) / SEQ; const float* gv = gate + (size_t)b * NMOD;
        const int row0 = u.pm * 256 + wr * 64 + fr, col0 = u.pn * 256 + wc * 32 + 8 * fq;
#pragma unroll
        for (int bj = 0; bj < 2; ++bj) {
            const int col = col0 + bj * 128;
            const pg8::f32x4 g0 = *(const pg8::f32x4*)(gv + col) * gs, g1 = *(const pg8::f32x4*)(gv + col + 4) * gs;
#pragma unroll
            for (int ai = 0; ai < 2; ++ai)
#pragma unroll
                for (int m = 0; m < 4; ++m) {
                    const size_t off = (size_t)(row0 + ai * 128 + m * 16) * DM + col;
                    const pg8::f32x4 x0 = *(const pg8::f32x4*)(xin + off), x1 = *(const pg8::f32x4*)(xin + off + 4);
                    *(pg8::f32x4*)(xout + off) = x0 + g0 * acc[ai][bj][m][0];
                    *(pg8::f32x4*)(xout + off + 4) = x1 + g1 * acc[ai][bj][m][1];
                }
        }
    }
};

#ifdef FUSE_GU
#define GU_PERM 2
#else
#define GU_PERM 0
#endif
constexpr size_t WS_SBTOP = WS_WIN, WS_SBBOT = WS_WIN + 6 * MiB;
template <int N> __device__ __forceinline__ float ror16(float v) { return __uint_as_float((unsigned)__builtin_amdgcn_update_dpp(0, (int)__float_as_uint(v), 0x120 + N, 0xF, 0xF, false)); }
struct EpiGU {
    static constexpr bool PERM = true, AFTER_DRAIN = false;
    bf16* act; const float* cw; const float* cb; float* sb_top; float* sb_bot; LAS float* T;
    __device__ __forceinline__ void operator()(const pg8::f32x4 (&acc)[2][2][4][2], const pg8::Unit& u, int wr, int wc, int fr, int fq) const {
        const int f0 = u.pn * 128 + wc * 32 + 8 * fq;
        float w0[8], w1[8], w2[8], bb[8];
        { const pg8::f32x4 a = *(const pg8::f32x4*)(cw + f0), b = *(const pg8::f32x4*)(cw + f0 + 4), c = *(const pg8::f32x4*)(cw + DFF + f0), d = *(const pg8::f32x4*)(cw + DFF + f0 + 4),
              e = *(const pg8::f32x4*)(cw + 2 * DFF + f0), g = *(const pg8::f32x4*)(cw + 2 * DFF + f0 + 4), h = *(const pg8::f32x4*)(cb + f0), k = *(const pg8::f32x4*)(cb + f0 + 4);
#pragma unroll
          for (int i = 0; i < 4; ++i) { w0[i] = a[i]; w0[4 + i] = b[i]; w1[i] = c[i]; w1[4 + i] = d[i]; w2[i] = e[i]; w2[4 + i] = g[i]; bb[i] = h[i]; bb[4 + i] = k[i]; } }
        if (fr >= 14) {
#pragma unroll
            for (int ai = 0; ai < 2; ++ai) { LAS float* t = T + ((((ai * 2 + wr) * 4 + wc) * 2 + (fr - 14)) * 4 + fq) * 8;
                *(LAS pg8::f32x4*)t = acc[ai][0][3][0]; *(LAS pg8::f32x4*)(t + 4) = acc[ai][0][3][1]; }
            if (wr == 1) { float* sb = sb_bot + (size_t)(u.pm * 2 + (fr - 14)) * DFF + f0; *(pg8::f32x4*)sb = acc[1][0][3][0]; *(pg8::f32x4*)(sb + 4) = acc[1][0][3][1]; }
        }
        if (wr == 0 && fr < 2) { float* sb = sb_top + (size_t)((u.pm * 2 + fr) * 2) * DFF + f0;
            *(pg8::f32x4*)sb = acc[0][0][0][0]; *(pg8::f32x4*)(sb + 4) = acc[0][0][0][1]; *(pg8::f32x4*)(sb + DFF) = acc[0][1][0][0]; *(pg8::f32x4*)(sb + DFF + 4) = acc[0][1][0][1]; }
        asm volatile("s_waitcnt lgkmcnt(0)" ::: "memory"); __builtin_amdgcn_s_barrier(); asm volatile("" ::: "memory");
        const int row0 = u.pm * 256 + wr * 64 + fr;
#pragma unroll
        for (int ai = 0; ai < 2; ++ai) {
            float P1[8], P2[8];
            if (ai == 0 && wr == 0) {
#pragma unroll
                for (int e = 0; e < 8; ++e) { P1[e] = 0.f; P2[e] = 0.f; }
            } else {
                const int sa = (wr == 1) ? ai : ai - 1, sw = (wr == 1) ? 0 : 1;
                const LAS float* t = T + (((sa * 2 + sw) * 4 + wc) * 2 * 4 + fq) * 8;
                const pg8::f32x4 r14a = *(const LAS pg8::f32x4*)t, r14b = *(const LAS pg8::f32x4*)(t + 4), r15a = *(const LAS pg8::f32x4*)(t + 32), r15b = *(const LAS pg8::f32x4*)(t + 36);
#pragma unroll
                for (int i = 0; i < 4; ++i) { P1[i] = r15a[i]; P1[4 + i] = r15b[i]; P2[i] = (fr == 0) ? r14a[i] : r15a[i]; P2[4 + i] = (fr == 0) ? r14b[i] : r15b[i]; }
            }
#pragma unroll
            for (int m = 0; m < 4; ++m) {
                float a[8];
#pragma unroll
                for (int e = 0; e < 8; ++e) {
                    const float g = acc[ai][0][m][e >> 2][e & 3], uu = acc[ai][1][m][e >> 2][e & 3];
                    const float R1 = ror16<1>(g), R2 = ror16<2>(g);
                    const float g1 = (fr >= 1) ? R1 : P1[e], g2 = (fr >= 2) ? R2 : P2[e];
                    const float gc = bb[e] + w0[e] * g2 + w1[e] * g1 + w2[e] * g;
                    a[e] = fast_silu(gc) * uu; P1[e] = R1; P2[e] = R2;
                }
                pg8::u32x4 w; w.x = pk2(a[0], a[1]); w.y = pk2(a[2], a[3]); w.z = pk2(a[4], a[5]); w.w = pk2(a[6], a[7]);
                *(pg8::u32x4*)(act + (size_t)(row0 + ai * 128 + m * 16) * DFF + f0) = w;
            }
        }
    }
};
struct BranchOrder {
    pg8::StaticOrder S;
    __device__ __forceinline__ bool next(int i, pg8::Unit& u) const { if (!S.next(i >> 1, u)) return false; u.br = i & 1; return true; }
    __device__ __forceinline__ void a_ready(const pg8::Unit&) const {}
    __device__ __forceinline__ void done(const pg8::Unit&) const {}
};

__device__ __forceinline__ void transpose_item(const float* W, int K, int N, bf16* WT, int row_off, int perm, LAS float* scr, int item, int lane) {
    const int nblk = N / 32, kb = item / nblk, nb = item % nblk, k0 = 64 * kb, n0 = 32 * nb;
#pragma unroll
    for (int i = 0; i < 32; ++i) { const int kk = 2 * i + (lane >> 5); scr[kk * 33 + (lane & 31)] = W[(size_t)(k0 + kk) * N + n0 + (lane & 31)]; }
    asm volatile("s_waitcnt lgkmcnt(0)" ::: "memory");
    const int d0 = perm == 1 ? ((n0 & ~255) + 128 * ((n0 >> 5) & 1) + 32 * ((n0 >> 6) & 3)) : perm == 2 ? ((n0 >> 7) * 256 + (n0 & 127)) : n0;
    const int c = lane & 7;
#pragma unroll
    for (int j = 0; j < 4; ++j) { const int n = (lane >> 3) + 8 * j; const LAS float* s = scr + (8 * c) * 33 + n;
        v4u o; o.x = pk2(s[0 * 33], s[1 * 33]); o.y = pk2(s[2 * 33], s[3 * 33]); o.z = pk2(s[4 * 33], s[5 * 33]); o.w = pk2(s[6 * 33], s[7 * 33]);
        *(v4u*)(WT + (size_t)(row_off + d0 + n) * K + k0 + 8 * c) = o; }
    asm volatile("s_waitcnt lgkmcnt(0)" ::: "memory");
}
__device__ __forceinline__ void rms_row_to_bf16(const float* xrow, bf16* orow, const float* gn, const float* sc, const float* sh, int lane) {
    const f32x4* xr = (const f32x4*)xrow + lane;
    f32x4 v[4]; float s = 0.f;
#pragma unroll
    for (int j = 0; j < 4; ++j) { v[j] = xr[64 * j]; s += (v[j].x * v[j].x + v[j].y * v[j].y) + (v[j].z * v[j].z + v[j].w * v[j].w); }
    const float rstd = 1.0f / sqrtf(wave_sum_l(s, lane) * (1.f / DM) + 1e-6f);
    unsigned long long* o8 = (unsigned long long*)orow + lane;
#pragma unroll
    for (int j = 0; j < 4; ++j) {
        const f32x4 g = ((const f32x4*)gn)[lane + 64 * j], c = ((const f32x4*)sc)[lane + 64 * j], h = ((const f32x4*)sh)[lane + 64 * j];
        const f32x4 y = (v[j] * rstd) * g * (c + 1.0f) + h;
        o8[64 * j] = (unsigned long long)pk2(y.x, y.y) | ((unsigned long long)pk2(y.z, y.w) << 32);
    }
}
__device__ __forceinline__ void sincos_acc(float ang, float& sn, float& cs) {
    const double a = (double)ang;
    const double kf = __builtin_rint(a * 0.6366197723675814);
    double r = __builtin_fma(-kf, 1.5707963267948966, a); r = __builtin_fma(-kf, 6.123233995736766e-17, r);
    const double r2 = r * r;
    double sp = -1.0 / 6227020800.0 * 0.0 + 1.0 / 6227020800.0;
    sp = sp * r2 - 1.0 / 39916800.0; sp = sp * r2 + 1.0 / 362880.0; sp = sp * r2 - 1.0 / 5040.0; sp = sp * r2 + 1.0 / 120.0; sp = sp * r2 - 1.0 / 6.0; sp = sp * r2 + 1.0;
    const double s = sp * r;
    double cp = 1.0 / 479001600.0;
    cp = cp * r2 - 1.0 / 3628800.0; cp = cp * r2 + 1.0 / 40320.0; cp = cp * r2 - 1.0 / 720.0; cp = cp * r2 + 1.0 / 24.0; cp = cp * r2 - 0.5; cp = cp * r2 + 1.0;
    const int q = ((int)kf) & 3;
    const double ss = (q == 0) ? s : (q == 1) ? cp : (q == 2) ? -s : -cp;
    const double cc = (q == 0) ? cp : (q == 1) ? -s : (q == 2) ? -cp : s;
    sn = (float)ss; cs = (float)cc;
}

constexpr int SWA_KP = 144, SWA_VP = 528;
__device__ __forceinline__ void swa_unit(int b, int kvh, int qblk, bf16* Qs, const bf16* Ks, const bf16* Vs, const float* sinks, LAS unsigned char* lds, bf16* dummy = nullptr) {
    const int tid = opaque_tid(), lane = tid & 63, r32 = lane & 31, hi = lane >> 5; const int wid = __builtin_amdgcn_readfirstlane(tid >> 6);
    const long rowbase = (long)b * SEQ; const int q0 = qblk * 128, kv0 = q0 - 128;
    LAS unsigned char* Kl = lds; LAS unsigned char* Vt = lds + 256 * SWA_KP;
#pragma unroll
    for (int i = 0; i < 4; ++i) {
        const int ch = tid + 512 * i, row = ch >> 3, c8 = ch & 7, kabs = kv0 + row;
        v4u kv = {0u, 0u, 0u, 0u}, vv = {0u, 0u, 0u, 0u};
        if (kabs >= 0) { kv = *(const v4u*)(Ks + (size_t)(rowbase + kabs) * 256 + kvh * 64 + c8 * 8); vv = *(const v4u*)(Vs + (size_t)(rowbase + kabs) * 256 + kvh * 64 + c8 * 8); }
        *(LAS v4u*)(Kl + row * SWA_KP + c8 * 16) = kv;
#pragma unroll
        for (int j = 0; j < 4; ++j) { const unsigned w = vv[j];
            *(LAS unsigned short*)(Vt + (c8 * 8 + 2 * j) * SWA_VP + row * 2) = (unsigned short)(w & 0xffffu);
            *(LAS unsigned short*)(Vt + (c8 * 8 + 2 * j + 1) * SWA_VP + row * 2) = (unsigned short)(w >> 16); }
    }
    __syncthreads();
#pragma unroll 1
    for (int tt = 0; tt < 2; ++tt) {
        const int task = wid * 2 + tt, g = task >> 2, t = task & 3, qh = kvh * 4 + g;
        bf16* qp = Qs + (size_t)(rowbase + q0 + 32 * t + r32) * 1024 + qh * 64 + hi * 8;
        bf16x8 qr[4];
#pragma unroll
        for (int d0 = 0; d0 < 4; ++d0) qr[d0] = *(const bf16x8*)(qp + d0 * 16);
        const float sink2 = sinks[qh] * LOG2E;
        f32x16 p[5];
#pragma unroll
        for (int jt = 0; jt < 5; ++jt) {
            const LAS unsigned char* kb = Kl + ((t + jt) * 32 + r32) * SWA_KP + hi * 16;
            f32x16 a = {};
#pragma unroll
            for (int d0 = 0; d0 < 4; ++d0) { const bf16x8 kf = *(const LAS bf16x8*)(kb + d0 * 32); a = __builtin_amdgcn_mfma_f32_32x32x16_bf16(kf, qr[d0], a, 0, 0, 0); }
            p[jt] = a;
        }
        float mx = sink2;
#pragma unroll
        for (int jt = 0; jt < 5; ++jt)
#pragma unroll
            for (int i = 0; i < 16; ++i) {
                const int cr = (i & 3) + 8 * (i >> 2) + 4 * hi, dlt = 128 + r32 - 32 * jt - cr, kabs = kv0 + (t + jt) * 32 + cr;
                const bool vis = (dlt >= 0) && (dlt < 128) && (kabs >= 0);
                p[jt][i] = vis ? p[jt][i] : -INFINITY; mx = fmaxf(mx, p[jt][i]);
            }
        mx = fmaxf(mx, shflx(mx, 32, lane));
        float sum = 0.f;
#pragma unroll
        for (int jt = 0; jt < 5; ++jt)
#pragma unroll
            for (int i = 0; i < 16; ++i) { const float e = __builtin_amdgcn_exp2f(p[jt][i] - mx); p[jt][i] = e; sum += e; }
        sum += shflx(sum, 32, lane);
        const float linv = 1.0f / (sum + __builtin_amdgcn_exp2f(sink2 - mx));
        f32x16 o[2]; o[0] = f32x16{}; o[1] = f32x16{};
#pragma unroll
        for (int jt = 0; jt < 5; ++jt)
#pragma unroll
            for (int s = 0; s < 2; ++s) {
                v4u pw; pw.x = pk2(p[jt][8 * s], p[jt][8 * s + 1]); pw.y = pk2(p[jt][8 * s + 2], p[jt][8 * s + 3]); pw.z = pk2(p[jt][8 * s + 4], p[jt][8 * s + 5]); pw.w = pk2(p[jt][8 * s + 6], p[jt][8 * s + 7]);
                const bf16x8 pa = __builtin_bit_cast(bf16x8, pw);
#pragma unroll
                for (int d0 = 0; d0 < 2; ++d0) {
                    const LAS unsigned char* vp = Vt + (d0 * 32 + r32) * SWA_VP + ((t + jt) * 32 + 16 * s + 4 * hi) * 2;
                    const s16x4 lo = *(const LAS s16x4*)vp, h4 = *(const LAS s16x4*)(vp + 16);
                    const bf16x8 vb = __builtin_shufflevector(lo, h4, 0, 1, 2, 3, 4, 5, 6, 7);
                    o[d0] = __builtin_amdgcn_mfma_f32_32x32x16_bf16(pa, vb, o[d0], 0, 0, 0);
                }
            }
        bf16* op = dummy ? dummy + (size_t)((q0 + 32 * t) & 4095) * 1024 + qh * 64 + r32 : Qs + (size_t)(rowbase + q0 + 32 * t) * 1024 + qh * 64 + r32;
#pragma unroll
        for (int i = 0; i < 16; ++i) {
            const int cr = (i & 3) + 8 * (i >> 2) + 4 * hi; const float li = __uint_as_float(__builtin_amdgcn_ds_bpermute(cr << 2, __float_as_uint(linv)));
            op[(size_t)cr * 1024] = (bf16)f2bf(o[0][i] * li); op[(size_t)cr * 1024 + 32] = (bf16)f2bf(o[1][i] * li);
        }
    }
    __syncthreads();
}

#define XB_TMO      128
#define XB_XCNT(j)  (256  + 64 * (j))
#define XB_XSUB(j)  (1280 + 64 * (j))
#define XB_XGEN(j)  (2304 + 64 * (j))
#define XB_TOP      3328
#define XB_TOPGEN   3392
#define XCD_BAR_WORDS 3456
#define XB_SPIN_CAP (1u << 18)

__device__ __forceinline__ unsigned xb_ld(unsigned* p)              { return __hip_atomic_load(p, __ATOMIC_RELAXED, __HIP_MEMORY_SCOPE_AGENT); }
__device__ __forceinline__ unsigned xb_add(unsigned* p, unsigned v) { return __hip_atomic_fetch_add(p, v, __ATOMIC_RELAXED, __HIP_MEMORY_SCOPE_AGENT); }
__device__ __forceinline__ unsigned xb_xcc_id() { return (unsigned)__builtin_amdgcn_s_getreg((3 << 11) | 20) & 0xFu; }
#define XB_SPIN(cond, bar) do { unsigned _sp = 0; while (cond) { __builtin_amdgcn_s_sleep(1); \
    if ((++_sp & 255u) == 0u) { if (xb_ld(&(bar)[XB_TMO])) break; if (_sp > XB_SPIN_CAP) { atomicAdd(&(bar)[XB_TMO], 1u); break; } } } } while (0)

struct XcdBarrier {
    unsigned* bar; unsigned x;
    volatile LAS unsigned* st;
};

__device__ __forceinline__ XcdBarrier xcd_barrier_post(unsigned* bar, volatile LAS unsigned* st) {
    XcdBarrier b; b.bar = bar; b.x = xb_xcc_id(); b.st = st;
    if (threadIdx.x == 0) (void)xb_add(&bar[XB_XCNT(b.x)], 1u);
    return b;
}
__device__ __forceinline__ void xcd_barrier_complete(unsigned* bar, unsigned x, unsigned& nloc, unsigned& nx) {
    const unsigned G = gridDim.x * gridDim.y * gridDim.z;
    unsigned sum, cnt, mine, sp = 0u;
    for (;;) {
        sum = 0u; cnt = 0u; mine = 0u;
#pragma unroll
        for (unsigned j = 0; j < 16; ++j) { const unsigned c = xb_ld(&bar[XB_XCNT(j)]); sum += c; cnt += (c > 0u) ? 1u : 0u; mine = (j == x) ? c : mine; }
        if (sum == G) break;
        __builtin_amdgcn_s_sleep(1);
        if ((++sp & 255u) == 0u) { if (xb_ld(&bar[XB_TMO])) break; if (sp > XB_SPIN_CAP) { atomicAdd(&bar[XB_TMO], 1u); break; } }
    }
    nloc = mine > 0u ? mine : 1u; nx = cnt > 0u ? cnt : 1u;
}

__device__ __forceinline__ void xcd_barrier(const XcdBarrier& b) {
    asm volatile("s_waitcnt vmcnt(0)" ::: "memory");
    __syncthreads();
    if (threadIdx.x == 0) {
        unsigned* bar = b.bar;
        __builtin_amdgcn_s_waitcnt(0);
        unsigned nloc = b.st[0], nx = b.st[1];
        if (nloc == 0u) { xcd_barrier_complete(bar, b.x, nloc, nx); b.st[0] = nloc; b.st[1] = nx; }
        const unsigned old = xb_add(&bar[XB_XSUB(b.x)], 1u);
        const unsigned gen = old / nloc;
        if (old + 1u == (gen + 1u) * nloc) {
            __builtin_amdgcn_fence(__ATOMIC_RELEASE, "agent");
            asm volatile("s_waitcnt vmcnt(0)" ::: "memory");
            const unsigned og = xb_add(&bar[XB_TOP], 1u);
            const unsigned tg = og / nx;
            if (og + 1u == (tg + 1u) * nx) xb_add(&bar[XB_TOPGEN], 1u);
            else XB_SPIN(xb_ld(&bar[XB_TOPGEN]) == tg, bar);
            __builtin_amdgcn_fence(__ATOMIC_ACQUIRE, "agent");
            xb_add(&bar[XB_XGEN(b.x)], 1u);
            asm volatile("s_waitcnt vmcnt(0)" ::: "memory");
        } else {
            XB_SPIN(xb_ld(&bar[XB_XGEN(b.x)]) == gen, bar);
            __builtin_amdgcn_fence(__ATOMIC_ACQUIRE, "agent");
            asm volatile("s_waitcnt vmcnt(0)" ::: "memory");
        }
    }
    __syncthreads();
}

#ifdef PROBE_SYNC2
#define GSYNC() do { xcd_barrier(xbar); xcd_barrier(xbar); } while (0)
#else
#define GSYNC() xcd_barrier(xbar)
#endif
#define PH_TID() const int tid = opaque_tid(), lane = tid & 63, wave = __builtin_amdgcn_readfirstlane(tid >> 6); (void)lane; (void)wave; \
    const int gw = vcu * 8 + wave, NGW = G * 8; (void)gw; (void)NGW; unsigned char* ws = ld_ws(); (void)ws
__global__ void __launch_bounds__(512, 2) fwd_megakernel(Params p) {
    extern __shared__ __attribute__((aligned(16))) unsigned char lds_raw[];
    cg::grid_group grid = cg::this_grid();
    LAS unsigned char* lds = (LAS unsigned char*)lds_raw;
    const int G = gridDim.x, bx = blockIdx.x;
    const int vcu = (G % 8 == 0) ? (bx % 8) * (G / 8) + bx / 8 : bx;
    volatile LAS unsigned* xst = (volatile LAS unsigned*)(lds + LDS_BYTES - 64);
    if (threadIdx.x < 2) xst[threadIdx.x] = 0u;
    __syncthreads();
    const XcdBarrier xbar = xcd_barrier_post((unsigned*)(p.ws + WS_BAR), xst);

#ifndef SKIP_P0
#ifdef PROBE_P02
    for (int rep_ = 0; rep_ < 2; ++rep_)
#endif
    {
        const int tid = threadIdx.x, lane = tid & 63, wave = __builtin_amdgcn_readfirstlane(tid >> 6); unsigned char* ws = p.ws;
        const float* c_in = p.in[1]; const int* pos = (const int*)p.in[2]; const float* w_ada = p.in[3]; const float* b_ada = p.in[4];
        float* mod = (float*)(ws + WS_MOD); float* rope = (float*)(ws + WS_ROPE);
#ifndef SKIP_ROPE
        for (int e0 = bx * 512; e0 < M * 32; e0 += G * 512) {
            const int e = e0 + tid; const int row = e >> 5, i = e & 31;
            const float inv_freq = (float)exp2(-(double)(2 * i) * (13.287712379549449 / 64.0));
            const float ang = (float)pos[row] * inv_freq;
            float sn, cs; sincos_acc(ang, sn, cs);
            rope[(size_t)row * 64 + i] = cs; rope[(size_t)row * 64 + 32 + i] = sn;
        }
#endif
#ifndef SKIP_MOD
        {
            LAS float* cact = (LAS float*)lds;
            LAS float* red = (LAS float*)(lds + 16384);
            for (int e = tid; e < NB * DM; e += 512) cact[e] = fast_silu(c_in[e]);
            __syncthreads();
            for (int unit = bx; unit < DEPTH * 96; unit += G) {
                const int l = unit / 96, col = (unit % 96) * 64 + lane;
                const float* Wp = w_ada + (size_t)l * DM * NMOD + (size_t)(wave * 128) * NMOD + col;
                float a0 = 0.f, a1 = 0.f, a2 = 0.f, a3 = 0.f;
#pragma unroll 8
                for (int kk = 0; kk < 128; ++kk) { const float w = Wp[(size_t)kk * NMOD]; const int k = wave * 128 + kk;
                    a0 += cact[k] * w; a1 += cact[1024 + k] * w; a2 += cact[2048 + k] * w; a3 += cact[3072 + k] * w; }
                red[(wave * 4 + 0) * 64 + lane] = a0; red[(wave * 4 + 1) * 64 + lane] = a1; red[(wave * 4 + 2) * 64 + lane] = a2; red[(wave * 4 + 3) * 64 + lane] = a3;
                __syncthreads();
                if (wave < 4) { float s = b_ada[(size_t)l * NMOD + col];
#pragma unroll
                    for (int w = 0; w < 8; ++w) s += red[(w * 4 + wave) * 64 + lane];
                    mod[(size_t)(l * NB + wave) * NMOD + col] = s; }
                __syncthreads();
            }
        }
#endif
    }
#endif
    grid.sync();

#pragma unroll 1
    for (int l = 0; l < DEPTH; ++l) {
#ifndef SKIP_P1
#ifdef PROBE_THIN2
        for (int rep_ = 0; rep_ < 2; ++rep_)
#endif
        {
            PH_TID();
            LAS float* scr = (LAS float*)(lds + wave * 16384);
            const float* xcur = (l == 0) ? inptr(p, 0) : (const float*)ld_out();
            const float* modl = (const float*)(ws + WS_MOD) + (size_t)l * NB * NMOD;
            const float* w_in = inptr(p, 6); const float* w_ba = inptr(p, 10); const float* w_bb = inptr(p, 11); const float* w_out = inptr(p, 12); const float* attn_norm = inptr(p, 5);
            constexpr int I_IN = 16 * (INW / 32), I_SQ = 16 * 32;
            for (int it = gw; it < I_IN + 3 * I_SQ; it += NGW) {
                int r = it;
                if (r < I_IN) { transpose_item(w_in + (size_t)l * DM * INW, DM, INW, (bf16*)(ws + WS_WIN), 0, 1, scr, r, lane); continue; } r -= I_IN;
                if (r < I_SQ) { transpose_item(w_ba + (size_t)l * DM * DM, DM, DM, (bf16*)(ws + WS_WA), 0, 0, scr, r, lane); continue; } r -= I_SQ;
                if (r < I_SQ) { transpose_item(w_bb + (size_t)l * DM * DM, DM, DM, (bf16*)(ws + WS_WB), 0, 0, scr, r, lane); continue; } r -= I_SQ;
                transpose_item(w_out + (size_t)l * DM * DM, DM, DM, (bf16*)(ws + WS_WO), 0, 0, scr, r, lane);
            }
            bf16* H = (bf16*)(ws + WS_H);
            for (int m = gw; m < M; m += NGW) { const float* mb = modl + (size_t)(m / SEQ) * NMOD;
                rms_row_to_bf16(xcur + (size_t)m * DM, H + (size_t)m * DM, attn_norm + l * DM, mb + 1024, mb, lane); }
        }
#endif
        GSYNC();
#ifndef SKIP_P2
#ifdef PROBE_GEMM2
        for (int rep_ = 0; rep_ < 2; ++rep_)
#endif
        {
            unsigned char* ws = ld_ws();
            pg8::Gemm g{(const bf16*)(ws + WS_H), (const bf16*)(ws + WS_WIN), DM, DM, DM, 0, 0}; pg8::StaticOrder S; S.init(M, INW, G, bx);
            EpiIn E{ws, (const float*)(ws + WS_ROPE)};
            pg8::gemm_phase<EpiIn, pg8::StaticOrder, PG8_ALIGN, PG8_SP2>(lds, g, S, E);
        }
#endif
        GSYNC();
#ifndef SKIP_P3
        {
#ifndef SKIP_ATTN
            float lam;
            { const int ln = opaque_tid() & 63; const float* lq = inptr(p, 7) + l * 256;
              const float s1 = wave_sum_l(lq[ln] * lq[64 + ln], ln), s2 = wave_sum_l(lq[128 + ln] * lq[192 + ln], ln);
              lam = __uint_as_float(__builtin_amdgcn_readfirstlane(__float_as_uint(expf(s1) - expf(s2) + lambda_init_of(l)))); }
#ifdef PROBE_ATTN2
            for (int rep_ = 0; rep_ < 2; ++rep_)
#endif
#ifdef ATT_V2
            const float* gsub = inptr(p, 8) + l * 128; const float onem = 1.0f - lambda_init_of(l);
            for (int it = vcu; it < 512; it += G) {
                const int bh = it >> 4, pr = it & 15, b = bh >> 3, h = bh & 7;
#pragma unroll 1
                for (int k = 0; k < 2; ++k) {
                    const int qb = k ? 31 - pr : pr;
#pragma unroll 1
                    for (int c = 0; c < 2; ++c)
                        attn_body::attn_unit<8>(b, 2 * h + c, h, qb, ld_ws(), (char*)lds_raw, c, lam, gsub, onem);
                }
            }
#else
            for (int it = vcu; it < 1024; it += G) {
                const int combo = it >> 4, pr = it & 15, b = combo >> 4, h = (combo >> 1) & 7, vh = combo & 1;
#pragma unroll 1
                for (int k = 0; k < 2; ++k) {
                    const int qb = k ? 31 - pr : pr;
#pragma unroll 1
                    for (int c = 0; c < 2; ++c)
                        attn_body::attn_unit<8>(b, 2 * h + c, 2 * h + vh, qb, ld_ws(), (char*)lds_raw, c, lam);
                }
            }
#endif
#endif
#ifndef SKIP_SWA
            { const float* sinks = inptr(p, 9) + l * 16;
#ifdef PROBE_SWA2
              for (int u = vcu; u < 1024; u += G) { unsigned char* ws = ld_ws(); swa_unit(u >> 8, (u >> 6) & 3, u & 63, (bf16*)(ws + WS_QS), (const bf16*)(ws + WS_KS), (const bf16*)(ws + WS_VS), sinks, lds, (bf16*)(ws + WS_WIN)); }
#endif
              for (int u = vcu; u < 1024; u += G) { unsigned char* ws = ld_ws(); swa_unit(u >> 8, (u >> 6) & 3, u & 63, (bf16*)(ws + WS_QS), (const bf16*)(ws + WS_KS), (const bf16*)(ws + WS_VS), sinks, lds); } }
#endif
        }
#endif
        GSYNC();
#ifndef ATT_V2
#ifndef SKIP_P4
#ifdef PROBE_THIN2
        for (int rep_ = 0; rep_ < 2; ++rep_)
#endif
        {
            PH_TID();
            const float* ssq = (const float*)(ws + WS_SSQ); const bf16* H = (const bf16*)(ws + WS_H); bf16* QA = (bf16*)(ws + WS_QA);
            const float* subln = inptr(p, 8); const float lam_init = lambda_init_of(l);
            for (int m = gw; m < M; m += NGW) {
                const int head = lane >> 3, e0 = (lane & 7) * 16;
                const float ss = ssq[(size_t)m * 16 + 2 * head] + ssq[(size_t)m * 16 + 2 * head + 1];
                const float rs = (1.0f / sqrtf(ss * (1.f / 128.f) + 1e-5f)) * (1.0f - lam_init);
                const v4u d0 = *(const v4u*)(H + (size_t)m * DM + lane * 16), d1 = *(const v4u*)(H + (size_t)m * DM + lane * 16 + 8);
                const float* gp = subln + l * 128 + e0;
                v4u o0, o1;
                o0.x = pk2(bflo(d0.x) * rs * gp[0], bfhi(d0.x) * rs * gp[1]); o0.y = pk2(bflo(d0.y) * rs * gp[2], bfhi(d0.y) * rs * gp[3]);
                o0.z = pk2(bflo(d0.z) * rs * gp[4], bfhi(d0.z) * rs * gp[5]); o0.w = pk2(bflo(d0.w) * rs * gp[6], bfhi(d0.w) * rs * gp[7]);
                o1.x = pk2(bflo(d1.x) * rs * gp[8], bfhi(d1.x) * rs * gp[9]); o1.y = pk2(bflo(d1.y) * rs * gp[10], bfhi(d1.y) * rs * gp[11]);
                o1.z = pk2(bflo(d1.z) * rs * gp[12], bfhi(d1.z) * rs * gp[13]); o1.w = pk2(bflo(d1.w) * rs * gp[14], bfhi(d1.w) * rs * gp[15]);
                *(v4u*)(QA + (size_t)m * DM + lane * 16) = o0; *(v4u*)(QA + (size_t)m * DM + lane * 16 + 8) = o1;
            }
        }
#endif
        GSYNC();
#endif
#ifndef SKIP_P5
#ifdef PROBE_GEMM2
        for (int rep_ = 0; rep_ < 2; ++rep_)
#endif
        {
            unsigned char* ws = ld_ws();
            pg8::Gemm g{(const bf16*)(ws + WS_QA), (const bf16*)(ws + WS_WA), DM, DM, DM, (size_t)(WS_QS - WS_QA), (size_t)(WS_WB - WS_WA)}; BranchOrder S; S.S.init(M, DM, G, bx);
            EpiBranch E{(const bf16*)(ws + WS_GATES), (bf16*)(ws + WS_MIXED)};
            pg8::gemm_phase<EpiBranch, BranchOrder, PG8_ALIGN, PG8_SP2>(lds, g, S, E);
        }
#endif
        GSYNC();
#ifndef SKIP_P6
#ifdef PROBE_RES2
        for (int repp6_ = 0; repp6_ < 2; ++repp6_)
#else
        const int repp6_ = 1;
#endif
        {
            unsigned char* ws = ld_ws();
            float* out = ld_out();
            const float* xcur = (l == 0) ? inptr(p, 0) : (const float*)out;
            pg8::Gemm g{(const bf16*)(ws + WS_MIXED), (const bf16*)(ws + WS_WO), DM, DM, DM, 0, 0}; pg8::StaticOrder S; S.init(M, DM, G, bx);
            EpiResid E{repp6_ ? xcur : (const float*)out, out, (const float*)(ws + WS_MOD) + (size_t)l * NB * NMOD + 2048, repp6_ ? 1.f : 0.f};
            pg8::gemm_phase<EpiResid, pg8::StaticOrder, PG8_ALIGN, PG8_SP2>(lds, g, S, E);
        }
#endif
        GSYNC();
#ifndef SKIP_P7
#ifdef PROBE_THIN2
        for (int rep_ = 0; rep_ < 2; ++rep_)
#endif
        {
            PH_TID();
            LAS float* scr = (LAS float*)(lds + wave * 16384);
            const float* out = (const float*)ld_out();
            const float* modl = (const float*)(ws + WS_MOD) + (size_t)l * NB * NMOD;
            const float* w_gate = inptr(p, 14); const float* w_up = inptr(p, 15); const float* w_down = inptr(p, 18); const float* ffn_norm = inptr(p, 13);
            constexpr int I_G = 16 * (DFF / 32), I_D = (DFF / 64) * 32;
            for (int it = gw; it < 2 * I_G + I_D; it += NGW) {
                int r = it;
                if (r < I_G) { transpose_item(w_gate + (size_t)l * DM * DFF, DM, DFF, (bf16*)(ws + WS_WGU), 0, GU_PERM, scr, r, lane); continue; } r -= I_G;
                if (r < I_G) { transpose_item(w_up + (size_t)l * DM * DFF, DM, DFF, (bf16*)(ws + WS_WGU), GU_PERM ? 128 : DFF, GU_PERM, scr, r, lane); continue; } r -= I_G;
                transpose_item(w_down + (size_t)l * DFF * DM, DFF, DM, (bf16*)(ws + WS_WD), 0, 0, scr, r, lane);
            }
            bf16* H = (bf16*)(ws + WS_H);
            for (int m = gw; m < M; m += NGW) { const float* mb = modl + (size_t)(m / SEQ) * NMOD;
                rms_row_to_bf16(out + (size_t)m * DM, H + (size_t)m * DM, ffn_norm + l * DM, mb + 4096, mb + 3072, lane); }
        }
#endif
        GSYNC();
#ifndef SKIP_P8
#ifdef PROBE_GEMM2
        for (int rep_ = 0; rep_ < 2; ++rep_)
#endif
        {
            unsigned char* ws = ld_ws();
            pg8::Gemm g{(const bf16*)(ws + WS_H), (const bf16*)(ws + WS_WGU), DM, DM, DM, 0, 0}; pg8::StaticOrder S; S.init(M, 2 * DFF, G, bx);
#ifdef FUSE_GU
            EpiGU E{(bf16*)(ws + WS_GU), inptr(p, 16) + (size_t)l * 3 * DFF, inptr(p, 17) + (size_t)l * DFF, (float*)(ws + WS_SBTOP), (float*)(ws + WS_SBBOT), (LAS float*)(lds + 131072)};
            pg8::gemm_phase<EpiGU, pg8::StaticOrder, PG8_ALIGN, PG8_SP2>(lds, g, S, E);
#else
            pg8::EpiBf16<0> E{(bf16*)(ws + WS_GU), 2 * DFF, nullptr, 0, 0, 1.f};
            pg8::gemm_phase<pg8::EpiBf16<0>, pg8::StaticOrder, PG8_ALIGN, PG8_SP2>(lds, g, S, E);
#endif
        }
#endif
        GSYNC();
#ifndef SKIP_P9
#ifdef FUSE_GU
        {
            PH_TID();
            bf16* ACT = (bf16*)(ws + WS_GU); const float* sbt = (const float*)(ws + WS_SBTOP); const float* sbb = (const float*)(ws + WS_SBBOT);
            const float* cw = inptr(p, 16) + (size_t)l * 3 * DFF; const float* cbp = inptr(p, 17) + (size_t)l * DFF;
            for (int w = bx * 512 + tid; w < (M / 256) * (DFF / 8); w += G * 512) {
                const int pm = w / (DFF / 8), c = (w % (DFF / 8)) * 8, r0 = pm * 256;
                const bool first = (r0 % SEQ) == 0;
#pragma unroll
                for (int hf = 0; hf < 2; ++hf) {
                    const int cc = c + 4 * hf;
                    const f32x4 g0 = *(const f32x4*)(sbt + (size_t)((pm * 2 + 0) * 2) * DFF + cc), u0 = *(const f32x4*)(sbt + (size_t)((pm * 2 + 0) * 2 + 1) * DFF + cc);
                    const f32x4 g1 = *(const f32x4*)(sbt + (size_t)((pm * 2 + 1) * 2) * DFF + cc), u1 = *(const f32x4*)(sbt + (size_t)((pm * 2 + 1) * 2 + 1) * DFF + cc);
                    f32x4 gm2 = {0.f, 0.f, 0.f, 0.f}, gm1 = {0.f, 0.f, 0.f, 0.f};
                    if (!first) { gm2 = *(const f32x4*)(sbb + (size_t)((pm - 1) * 2 + 0) * DFF + cc); gm1 = *(const f32x4*)(sbb + (size_t)((pm - 1) * 2 + 1) * DFF + cc); }
                    const f32x4 k0 = *(const f32x4*)(cw + cc), k1 = *(const f32x4*)(cw + DFF + cc), k2 = *(const f32x4*)(cw + 2 * DFF + cc), kb = *(const f32x4*)(cbp + cc);
                    const f32x4 ga = kb + k0 * gm2 + k1 * gm1 + k2 * g0, gb = kb + k0 * gm1 + k1 * g0 + k2 * g1;
                    float a0[4], a1[4];
#pragma unroll
                    for (int i = 0; i < 4; ++i) { a0[i] = fast_silu(ga[i]) * u0[i]; a1[i] = fast_silu(gb[i]) * u1[i]; }
                    *(unsigned long long*)(ACT + (size_t)r0 * DFF + cc) = (unsigned long long)pk2(a0[0], a0[1]) | ((unsigned long long)pk2(a0[2], a0[3]) << 32);
                    *(unsigned long long*)(ACT + (size_t)(r0 + 1) * DFF + cc) = (unsigned long long)pk2(a1[0], a1[1]) | ((unsigned long long)pk2(a1[2], a1[3]) << 32);
                }
            }
        }
#else
#ifdef PROBE_THIN2
        for (int repp9_ = 0; repp9_ < 2; ++repp9_)
#else
        const int repp9_ = 1;
#endif
        {
            PH_TID();
            bf16* GU = (bf16*)(ws + WS_GU); const float* conv_w = inptr(p, 16); const float* conv_b = inptr(p, 17);
            for (int item = bx; item < M / 64; item += G) {
                if (tid < DFF / 8) {
                    const int col = tid * 8, r0 = item * 64;
                    float cw0[8], cw1[8], cw2[8], cb[8], gm2[8], gm1[8];
#pragma unroll
                    for (int j = 0; j < 8; ++j) { cw0[j] = conv_w[(size_t)(l * 3 + 0) * DFF + col + j]; cw1[j] = conv_w[(size_t)(l * 3 + 1) * DFF + col + j]; cw2[j] = conv_w[(size_t)(l * 3 + 2) * DFF + col + j];
                        cb[j] = conv_b[(size_t)l * DFF + col + j]; gm2[j] = 0.f; gm1[j] = 0.f; }
                    if ((r0 % SEQ) != 0) {
                        const v4u a = *(const v4u*)(GU + (size_t)(r0 - 2) * (2 * DFF) + col), bq = *(const v4u*)(GU + (size_t)(r0 - 1) * (2 * DFF) + col);
                        gm2[0] = bflo(a.x); gm2[1] = bfhi(a.x); gm2[2] = bflo(a.y); gm2[3] = bfhi(a.y); gm2[4] = bflo(a.z); gm2[5] = bfhi(a.z); gm2[6] = bflo(a.w); gm2[7] = bfhi(a.w);
                        gm1[0] = bflo(bq.x); gm1[1] = bfhi(bq.x); gm1[2] = bflo(bq.y); gm1[3] = bfhi(bq.y); gm1[4] = bflo(bq.z); gm1[5] = bfhi(bq.z); gm1[6] = bflo(bq.w); gm1[7] = bfhi(bq.w);
                    }
#pragma unroll 8
                    for (int r = 0; r < 64; ++r) {
                        bf16* gp = GU + (size_t)(r0 + r) * (2 * DFF) + col;
                        const v4u gv = *(const v4u*)gp, uv = *(const v4u*)(gp + DFF);
                        float gq[8], uq[8], a[8];
                        gq[0] = bflo(gv.x); gq[1] = bfhi(gv.x); gq[2] = bflo(gv.y); gq[3] = bfhi(gv.y); gq[4] = bflo(gv.z); gq[5] = bfhi(gv.z); gq[6] = bflo(gv.w); gq[7] = bfhi(gv.w);
                        uq[0] = bflo(uv.x); uq[1] = bfhi(uv.x); uq[2] = bflo(uv.y); uq[3] = bfhi(uv.y); uq[4] = bflo(uv.z); uq[5] = bfhi(uv.z); uq[6] = bflo(uv.w); uq[7] = bfhi(uv.w);
#pragma unroll
                        for (int j = 0; j < 8; ++j) { const float gc = cb[j] + cw0[j] * gm2[j] + cw1[j] * gm1[j] + cw2[j] * gq[j]; a[j] = fast_silu(gc) * uq[j]; gm2[j] = gm1[j]; gm1[j] = gq[j]; }
                        v4u o; o.x = pk2(a[0], a[1]); o.y = pk2(a[2], a[3]); o.z = pk2(a[4], a[5]); o.w = pk2(a[6], a[7]);
                        *(v4u*)(gp + DFF) = repp9_ ? o : uv;
                    }
                }
            }
        }
#endif
#endif
        GSYNC();
#ifndef SKIP_P10
#ifdef PROBE_RES2
        for (int repp10_ = 0; repp10_ < 2; ++repp10_)
#else
        const int repp10_ = 1;
#endif
        {
            unsigned char* ws = ld_ws();
            float* out = ld_out();
            #ifdef FUSE_GU
            pg8::Gemm g{(const bf16*)(ws + WS_GU), (const bf16*)(ws + WS_WD), DFF, DFF, DFF, 0, 0};
#else
            pg8::Gemm g{(const bf16*)(ws + WS_GU) + DFF, (const bf16*)(ws + WS_WD), 2 * DFF, DFF, DFF, 0, 0};
#endif
            pg8::StaticOrder S; S.init(M, DM, G, bx);
            EpiResid E{out, out, (const float*)(ws + WS_MOD) + (size_t)l * NB * NMOD + 5120, repp10_ ? 1.f : 0.f};
            pg8::gemm_phase<EpiResid, pg8::StaticOrder, PG8_ALIGN, PG8_SP2>(lds, g, S, E);
        }
#endif
        GSYNC();
    }
    {
        PH_TID();
        float* out = ld_out(); const float* final_norm = inptr(p, 19);
        for (int m = gw; m < M; m += NGW) {
            f32x4* xr = (f32x4*)(out + (size_t)m * DM) + lane;
            f32x4 v[4]; float s = 0.f;
#pragma unroll
            for (int j = 0; j < 4; ++j) { v[j] = xr[64 * j]; s += (v[j].x * v[j].x + v[j].y * v[j].y) + (v[j].z * v[j].z + v[j].w * v[j].w); }
            const float rstd = 1.0f / sqrtf(wave_sum_l(s, lane) * (1.f / DM) + 1e-6f);
#pragma unroll
            for (int j = 0; j < 4; ++j) xr[64 * j] = (v[j] * rstd) * ((const f32x4*)final_norm)[lane + 64 * j];
        }
    }
}

extern "C" void kernel_launch(void* const* d_in, const int* in_sizes, int n_in, void* d_out, int out_size, void* d_ws, size_t ws_size, hipStream_t stream) {
    static int grid_blocks = 0;
    if (grid_blocks == 0) {
        if (n_in != 20 || ws_size < WS_END || out_size != M * DM) { fprintf(stderr, "kernel_launch: unexpected problem (n_in %d, ws %zu, out %d)\n", n_in, ws_size, out_size); grid_blocks = -1; return; }
        int dev = 0, cus = 0, per_cu = 0;
        hipGetDevice(&dev);
        hipDeviceGetAttribute(&cus, hipDeviceAttributeMultiprocessorCount, dev);
        hipFuncSetAttribute((const void*)fwd_megakernel, hipFuncAttributeMaxDynamicSharedMemorySize, LDS_BYTES);
        hipOccupancyMaxActiveBlocksPerMultiprocessor(&per_cu, (const void*)fwd_megakernel, 512, LDS_BYTES);
        if (per_cu < 1) per_cu = 1;
        grid_blocks = cus * per_cu;
        (void)hipGetLastError();
    }
    if (grid_blocks < 0) return;
    if (hipMemsetAsync((char*)d_ws + WS_BAR, 0, 16384, stream) != hipSuccess) { fprintf(stderr, "memset failed\n"); return; }
    Params p{};
    for (int i = 0; i < 20; ++i) p.in[i] = (const float*)d_in[i];
    p.out = (float*)d_out; p.ws = (unsigned char*)d_ws;
    void* args[] = {&p};
    hipError_t e = hipLaunchCooperativeKernel((const void*)fwd_megakernel, dim3(grid_blocks), dim3(512), args, LDS_BYTES, stream);
    if (e != hipSuccess) fprintf(stderr, "cooperative launch failed: %s (grid %d)\n", hipGetErrorString(e), grid_blocks);
}
```
